# Optimizing an MI355X kernel written in HIP

```python
import math
import jax, jax.numpy as jnp
from jax import lax
import numpy as np

D_MODEL = 1024
BATCH = 16
SEQ = 4096
DEPTH = 1

HEAD_DIM = 64
NSA_KV_GROUPS = 2
NSA_HEADS = (D_MODEL // 2) // HEAD_DIM
NSA_HPG = NSA_HEADS // NSA_KV_GROUPS
NSA_WIDTH = NSA_HEADS * HEAD_DIM
NSA_BRANCHES = 3
CMP_BLOCK = 32
CMP_STRIDE = 16
CMP_HIDDEN = 256
SEL_BLOCK = 64
SEL_TOPN = 16
WINDOW = 512
DIFF_QK_DIM = 64
DIFF_V_DIM = 2 * DIFF_QK_DIM
DIFF_HEADS = (D_MODEL - NSA_WIDTH) // DIFF_V_DIM
DIFF_WIDTH = DIFF_HEADS * DIFF_V_DIM
MIX_WIDTH = NSA_WIDTH + DIFF_WIDTH
N_ATTN_HEADS = NSA_HEADS + DIFF_HEADS
OFF_NSA_KV = NSA_WIDTH
OFF_NSA_GATE = OFF_NSA_KV + NSA_BRANCHES * 2 * NSA_KV_GROUPS * HEAD_DIM
OFF_DIFF_Q = OFF_NSA_GATE + NSA_HEADS * NSA_BRANCHES
OFF_DIFF_K = OFF_DIFF_Q + DIFF_HEADS * 2 * DIFF_QK_DIM
OFF_DIFF_V = OFF_DIFF_K + DIFF_HEADS * 2 * DIFF_QK_DIM
IN_COLS = OFF_DIFF_V + DIFF_WIDTH
REL_BUCKETS = 32
REL_MAX_DIST = 128
PEER_HEADS = 8
PEER_NKEYS = 128
PEER_EXPERTS = PEER_NKEYS ** 2
PEER_TOPK = 16
PEER_QDIM = 256
QBLOCK = 128
PEER_CHUNK = 128
RMS_EPS = 1e-6
NEG_INF = -1e30
FORCED_SCORE = 1e9

kernel_name = 'hybrid_nsa_diffattn_peer_block'


def rmsnorm(x, g):
    xf = x.astype(jnp.float32)
    y = xf * lax.rsqrt(jnp.mean(xf * xf, axis=-1, keepdims=True) + RMS_EPS)
    return (y * g.astype(jnp.float32)).astype(x.dtype)


def t5_bucket(dist):
    n = jnp.maximum(dist, 0)
    max_exact = REL_BUCKETS // 2
    nf = jnp.maximum(n, 1).astype(jnp.float32)
    large = max_exact + (jnp.log(nf / max_exact) / math.log(REL_MAX_DIST / max_exact)
                         * (REL_BUCKETS - max_exact)).astype(jnp.int32)
    return jnp.where(n < max_exact, n, jnp.minimum(large, REL_BUCKETS - 1))


def masked_softmax(logits, mask):
    p = jax.nn.softmax(jnp.where(mask, logits, NEG_INF), axis=-1)
    return p * mask.astype(p.dtype)


def compress_blocks(tok, pos_enc, w1, w2, starts):
    idx = starts[:, None] + np.arange(CMP_BLOCK)[None, :]
    blocks = tok[:, idx] + pos_enc[None, None, :, None, :].astype(tok.dtype)
    b, nc = blocks.shape[:2]
    flat = blocks.transpose(0, 1, 3, 2, 4).reshape(b, nc, NSA_KV_GROUPS, CMP_BLOCK * HEAD_DIM)
    return jax.nn.gelu(flat @ w1) @ w2


def block_overlap(cmp_start, n_sel):
    sel_start = np.arange(n_sel) * SEL_BLOCK
    lo = np.maximum(cmp_start[:, None], sel_start[None, :])
    hi = np.minimum(cmp_start[:, None] + CMP_BLOCK, sel_start[None, :] + SEL_BLOCK)
    return np.maximum(hi - lo, 0).astype(np.float32) / CMP_BLOCK


def nsa_diff_mixer(h, w_in, w_out, rel_bias, cmp_pos, cmp_w1, cmp_w2,
                   lam_q1, lam_k1, lam_q2, lam_k2, subln_g, layer_idx):
    bsz, s, _ = h.shape
    dt = h.dtype
    f32 = jnp.float32
    G, HPG, DH = NSA_KV_GROUPS, NSA_HPG, HEAD_DIM
    proj = h @ w_in
    q_nsa = proj[..., :OFF_NSA_KV].reshape(bsz, s, G, HPG, DH)
    kv = proj[..., OFF_NSA_KV:OFF_NSA_GATE].reshape(bsz, s, NSA_BRANCHES, 2, G, DH)
    gates = jax.nn.sigmoid(proj[..., OFF_NSA_GATE:OFF_DIFF_Q]).reshape(bsz, s, G, HPG, NSA_BRANCHES)
    dq = proj[..., OFF_DIFF_Q:OFF_DIFF_K].reshape(bsz, s, DIFF_HEADS, 2, DIFF_QK_DIM)
    dk = proj[..., OFF_DIFF_K:OFF_DIFF_V].reshape(bsz, s, DIFF_HEADS, 2, DIFF_QK_DIM)
    dv = proj[..., OFF_DIFF_V:].reshape(bsz, s, DIFF_HEADS, DIFF_V_DIM)

    n_cmp = (s - CMP_BLOCK) // CMP_STRIDE + 1
    cmp_start = np.arange(n_cmp) * CMP_STRIDE
    k_cmp = compress_blocks(kv[:, :, 0, 0], cmp_pos[0], cmp_w1[0], cmp_w2[0], cmp_start)
    v_cmp = compress_blocks(kv[:, :, 0, 1], cmp_pos[1], cmp_w1[1], cmp_w2[1], cmp_start)
    cmp_end = jnp.asarray(cmp_start + CMP_BLOCK - 1, jnp.int32)
    n_sel = s // SEL_BLOCK
    n_top = min(SEL_TOPN, n_sel)
    cmp_to_sel = jnp.asarray(block_overlap(cmp_start, n_sel))
    k_sel = kv[:, :, 1, 0].reshape(bsz, n_sel, SEL_BLOCK, G, DH).transpose(0, 3, 1, 2, 4)
    v_sel = kv[:, :, 1, 1].reshape(bsz, n_sel, SEL_BLOCK, G, DH).transpose(0, 3, 1, 2, 4)
    pad = ((0, 0), (WINDOW, 0), (0, 0), (0, 0))
    k_win = jnp.pad(kv[:, :, 2, 0], pad)
    v_win = jnp.pad(kv[:, :, 2, 1], pad)

    tab_nsa = rel_bias[:, :NSA_HEADS].astype(f32).reshape(REL_BUCKETS, G, HPG)
    tab_nsa_g = tab_nsa.transpose(1, 0, 2)
    tab_diff = rel_bias[:, NSA_HEADS:].astype(f32)

    lam_init = 0.8 - 0.6 * math.exp(-0.3 * layer_idx)
    lam = (jnp.exp(jnp.sum(lam_q1.astype(f32) * lam_k1.astype(f32)))
           - jnp.exp(jnp.sum(lam_q2.astype(f32) * lam_k2.astype(f32))) + lam_init)

    scale = HEAD_DIM ** -0.5
    scale_d = DIFF_QK_DIM ** -0.5
    n_qb = s // QBLOCK
    q_offs = jnp.arange(QBLOCK)
    tok_offs = jnp.arange(SEL_BLOCK)
    blk_ids = jnp.arange(n_sel)
    win_offs = jnp.arange(WINDOW + QBLOCK)
    key_pos = jnp.arange(s)
    g_ids = jnp.arange(G)[:, None, None]

    def rows(a, b, start, size):
        return lax.dynamic_slice(a, (b, start) + (0,) * (a.ndim - 2), (1, size) + a.shape[2:])[0]

    def batch(a, b):
        return lax.dynamic_index_in_dim(a, b, 0, keepdims=False)

    def query_block(i):
        b = i // n_qb
        q0 = (i % n_qb) * QBLOCK
        t = q0 + q_offs
        q = rows(q_nsa, b, q0, QBLOCK)
        gt = rows(gates, b, q0, QBLOCK)

        d_c = t[:, None] - cmp_end[None, :]
        lg_c = (jnp.einsum('tghd,cgd->ghtc', q, batch(k_cmp, b)).astype(f32) * scale
                + tab_nsa[t5_bucket(d_c)].transpose(2, 3, 0, 1))
        p_c = masked_softmax(lg_c, d_c >= 0)
        o_c = jnp.einsum('ghtc,cgd->tghd', p_c.astype(dt), batch(v_cmp, b))

        imp = jnp.einsum('ghtc,cj->gtj', p_c, cmp_to_sel)
        cur = (t // SEL_BLOCK)[:, None]
        forced = (blk_ids == 0) | (blk_ids == cur) | (blk_ids == cur - 1)
        score = jnp.where(forced, FORCED_SCORE, jnp.where(blk_ids <= cur, imp, NEG_INF))
        _, sel = lax.top_k(score, n_top)
        sel_pos = sel[..., None] * SEL_BLOCK + tok_offs
        d_s = t[None, :, None, None] - sel_pos
        nk = n_top * SEL_BLOCK
        ks_g = batch(k_sel, b)[g_ids, sel].reshape(G, QBLOCK, nk, DH)
        vs_g = batch(v_sel, b)[g_ids, sel].reshape(G, QBLOCK, nk, DH)
        b_s = jnp.moveaxis(tab_nsa_g[g_ids[..., None], t5_bucket(d_s)], -1, 1).reshape(G, HPG, QBLOCK, nk)
        lg_s = jnp.einsum('tghd,gtkd->ghtk', q, ks_g).astype(f32) * scale + b_s
        p_s = masked_softmax(lg_s, (d_s >= 0).reshape(G, 1, QBLOCK, nk))
        o_s = jnp.einsum('ghtk,gtkd->tghd', p_s.astype(dt), vs_g)

        kp = q0 - WINDOW + win_offs
        d_w = t[:, None] - kp[None, :]
        ok_w = (d_w >= 0) & (d_w < WINDOW) & (kp >= 0)[None, :]
        lg_w = (jnp.einsum('tghd,sgd->ghts', q, rows(k_win, b, q0, WINDOW + QBLOCK)).astype(f32) * scale
                + tab_nsa[t5_bucket(d_w)].transpose(2, 3, 0, 1))
        p_w = masked_softmax(lg_w, ok_w)
        o_w = jnp.einsum('ghts,sgd->tghd', p_w.astype(dt), rows(v_win, b, q0, WINDOW + QBLOCK))

        o_nsa = (gt[..., 0:1] * o_c + gt[..., 1:2] * o_s + gt[..., 2:3] * o_w).reshape(QBLOCK, NSA_WIDTH)

        qd = rows(dq, b, q0, QBLOCK)
        d_d = t[:, None] - key_pos[None, :]
        lg_d = (jnp.einsum('thmd,shmd->mhts', qd, batch(dk, b)).astype(f32) * scale_d
                + tab_diff[t5_bucket(d_d)].transpose(2, 0, 1)[None])
        p_d = masked_softmax(lg_d, d_d >= 0)
        o_d = jnp.einsum('hts,shd->thd', (p_d[0] - lam * p_d[1]).astype(dt), batch(dv, b))
        o_d = rmsnorm(o_d, subln_g) * (1.0 - lam_init)
        return jnp.concatenate([o_nsa, o_d.reshape(QBLOCK, DIFF_WIDTH)], axis=-1)

    mixed = lax.map(query_block, jnp.arange(bsz * n_qb)).reshape(bsz, s, MIX_WIDTH)
    return mixed @ w_out


def peer_ffn(h, wq, sub_keys, u, v):
    bsz, s, d = h.shape
    dt = h.dtype
    chunks = h.reshape(bsz * s // PEER_CHUNK, PEER_CHUNK, d)
    kk = PEER_TOPK * PEER_TOPK

    def body(xc):
        q = (xc @ wq).reshape(PEER_CHUNK, PEER_HEADS, 2, PEER_QDIM // 2)
        sub = jnp.einsum('thpd,pkd->thpk', q, sub_keys).astype(jnp.float32)
        sv, si = lax.top_k(sub, PEER_TOPK)
        cand = (sv[:, :, 0, :, None] + sv[:, :, 1, None, :]).reshape(PEER_CHUNK, PEER_HEADS, kk)
        cidx = (si[:, :, 0, :, None] * PEER_NKEYS + si[:, :, 1, None, :]).reshape(PEER_CHUNK, PEER_HEADS, kk)
        best, pos = lax.top_k(cand, PEER_TOPK)
        eid = jnp.take_along_axis(cidx, pos, axis=-1)
        g = jax.nn.softmax(best, axis=-1).astype(dt)
        act = jax.nn.gelu(jnp.einsum('td,thkd->thk', xc, u[eid]))
        return jnp.einsum('thk,thkd->td', g * act, v[eid])

    return lax.map(body, chunks).reshape(bsz, s, d)


def setup_inputs(seed: int = 0) -> dict:
    key = jax.random.key(seed)
    ks = jax.random.split(key, 22)
    f32 = jnp.float32
    L, D = DEPTH, D_MODEL

    def nrm(k, shape, sd):
        return sd * jax.random.normal(k, shape, f32)

    return {
        'x': nrm(ks[0], (BATCH, SEQ, D), 1.0),
        'c': nrm(ks[1], (BATCH, D), 1.0),
        'rel_bias': nrm(ks[2], (REL_BUCKETS, N_ATTN_HEADS), 0.5),
        'ada_w': nrm(ks[3], (L, D, 6 * D), 0.5 * D ** -0.5),
        'ada_b': nrm(ks[4], (L, 6 * D), 0.02),
        'norm1_g': 1.0 + nrm(ks[5], (L, D), 0.02),
        'norm2_g': 1.0 + nrm(ks[6], (L, D), 0.02),
        'w_in': nrm(ks[7], (L, D, IN_COLS), D ** -0.5),
        'w_out': nrm(ks[8], (L, MIX_WIDTH, D), MIX_WIDTH ** -0.5),
        'cmp_pos': nrm(ks[9], (L, 2, CMP_BLOCK, HEAD_DIM), 0.02),
        'cmp_w1': nrm(ks[10], (L, 2, CMP_BLOCK * HEAD_DIM, CMP_HIDDEN), (CMP_BLOCK * HEAD_DIM) ** -0.5),
        'cmp_w2': nrm(ks[11], (L, 2, CMP_HIDDEN, HEAD_DIM), CMP_HIDDEN ** -0.5),
        'lam_q1': nrm(ks[12], (L, DIFF_QK_DIM), 0.1),
        'lam_k1': nrm(ks[13], (L, DIFF_QK_DIM), 0.1),
        'lam_q2': nrm(ks[14], (L, DIFF_QK_DIM), 0.1),
        'lam_k2': nrm(ks[15], (L, DIFF_QK_DIM), 0.1),
        'diff_subln_g': 1.0 + nrm(ks[16], (L, DIFF_V_DIM), 0.02),
        'peer_wq': nrm(ks[17], (L, D, PEER_HEADS * PEER_QDIM), D ** -0.5),
        'peer_sub_keys': nrm(ks[18], (L, 2, PEER_NKEYS, PEER_QDIM // 2), (PEER_QDIM // 2) ** -0.5),
        'peer_u': nrm(ks[19], (L, PEER_EXPERTS, D), D ** -0.5),
        'peer_v': nrm(ks[20], (L, PEER_EXPERTS, D), 1.0),
        'final_g': 1.0 + nrm(ks[21], (D,), 0.02),
    }


def reference(x, c, rel_bias, ada_w, ada_b, norm1_g, norm2_g, w_in, w_out, cmp_pos, cmp_w1, cmp_w2,
              lam_q1, lam_k1, lam_q2, lam_k2, diff_subln_g, peer_wq, peer_sub_keys, peer_u, peer_v, final_g):
    cond = jax.nn.silu(c)
    for l in range(DEPTH):
        mod = (cond @ ada_w[l] + ada_b[l]).reshape(c.shape[0], 6, 1, D_MODEL)
        sh_a, sc_a, g_a, sh_f, sc_f, g_f = (mod[:, i] for i in range(6))
        h = rmsnorm(x, norm1_g[l]) * (1 + sc_a) + sh_a
        x = x + g_a * nsa_diff_mixer(h, w_in[l], w_out[l], rel_bias, cmp_pos[l], cmp_w1[l], cmp_w2[l],
                                     lam_q1[l], lam_k1[l], lam_q2[l], lam_k2[l], diff_subln_g[l], l)
        h = rmsnorm(x, norm2_g[l]) * (1 + sc_f) + sh_f
        x = x + g_f * peer_ffn(h, peer_wq[l], peer_sub_keys[l], peer_u[l], peer_v[l])
    return rmsnorm(x, final_g)
```

```cpp
#include <hip/hip_runtime.h>
#include <hip/hip_cooperative_groups.h>
#include <cstdio>
#include <cstdint>
namespace cg = cooperative_groups;

#ifndef MK_SPLIT
#define MK_SPLIT 0
#endif

#define DI __device__ __forceinline__
typedef unsigned short bf16_t;
typedef short bf16x8 __attribute__((ext_vector_type(8)));
typedef short s16x4 __attribute__((ext_vector_type(4)));
typedef float f32x4 __attribute__((ext_vector_type(4)));
typedef float f32x16 __attribute__((ext_vector_type(16)));
typedef unsigned u32x4 __attribute__((ext_vector_type(4)));
typedef unsigned u32x2 __attribute__((ext_vector_type(2)));
typedef __bf16 bf16x2_t __attribute__((ext_vector_type(2)));
typedef float f32x2_t __attribute__((ext_vector_type(2)));

#define MFMA32(a, b, c) __builtin_amdgcn_mfma_f32_32x32x16_bf16((a), (b), (c), 0, 0, 0)
#define MFMA16(a, b, c) __builtin_amdgcn_mfma_f32_16x16x32_bf16((a), (b), (c), 0, 0, 0)

constexpr int NB = 16, SEQ = 4096, DM = 1024, NTOK = NB * SEQ;
constexpr int NIN_PAD = 2944;
constexpr int NTHREADS = 512;
constexpr float LOG2E = 1.4426950408889634f;
constexpr float QSCALE = 0.125f * LOG2E;
constexpr float NEGB = -1e30f;
constexpr float RMS_EPS = 1e-6f;
constexpr int LDS_BYTES = 163840;

constexpr size_t MiB = 1u << 20;
constexpr size_t OFF_MOD = 0, OFF_TAB = 512 * 1024, OFF_PB = 520 * 1024, OFF_BAR = 768 * 1024;
constexpr size_t OFF_SK = 1 * MiB, OFF_W2T = 1 * MiB + 128 * 1024;
constexpr size_t OFF_W1T = 2 * MiB, OFF_WOUTT = 4 * MiB, OFF_WQT = 6 * MiB, OFF_WINT = 10 * MiB;
constexpr size_t OFF_HID = 16 * MiB, OFF_KCMP = 24 * MiB, OFF_VCMPT = 25 * MiB;
constexpr size_t OFF_U = 32 * MiB, OFF_V = 64 * MiB;
constexpr size_t OFF_US = 48 * MiB, OFF_VS = 80 * MiB;
constexpr size_t OFF_H = 96 * MiB;
constexpr size_t OFF_X1 = 224 * MiB;
constexpr size_t OFF_EID = 480 * MiB, OFF_GW = 512 * MiB;
constexpr size_t OFF_PROJ = 544 * MiB;
constexpr size_t OFF_QN = OFF_PROJ, OFF_KC = OFF_PROJ + 64 * MiB, OFF_VC = OFF_PROJ + 80 * MiB, OFF_KS = OFF_PROJ + 96 * MiB,
                 OFF_VST = OFF_PROJ + 112 * MiB, OFF_KW = OFF_PROJ + 128 * MiB, OFF_VWT = OFF_PROJ + 144 * MiB,
                 OFF_GATES = OFF_PROJ + 160 * MiB, OFF_DQ = OFF_PROJ + 168 * MiB, OFF_DK = OFF_PROJ + 232 * MiB,
                 OFF_DVT = OFF_PROJ + 296 * MiB;
constexpr size_t OFF_QP = OFF_PROJ;
constexpr size_t WS_NEED = 904 * MiB;

struct Params {
    const float *x, *c, *rel_bias, *ada_w, *ada_b, *norm1_g, *norm2_g, *w_in, *w_out, *cmp_pos, *cmp_w1, *cmp_w2,
                *lam_q1, *lam_k1, *lam_q2, *lam_k2, *subln_g, *peer_wq, *peer_sub, *peer_u, *peer_v, *final_g;
    float* out;
    unsigned char* ws;
    int ph_lo, ph_hi;
};

DI unsigned pk2(float lo, float hi) { f32x2_t v = {lo, hi}; bf16x2_t b = __builtin_convertvector(v, bf16x2_t); return __builtin_bit_cast(unsigned, b); }
DI float bf_lo(unsigned w) { return __uint_as_float(w << 16); }
DI float bf_hi(unsigned w) { return __uint_as_float(w & 0xffff0000u); }
DI float wave_sum(float v) {
#pragma unroll
    for (int o = 1; o < 64; o <<= 1) v += __shfl_xor(v, o);
    return v;
}
DI float gelu_tanh(float x) {
    const float u = 0.7978845608028654f * (x + 0.044715f * x * x * x);
    const float e = __builtin_amdgcn_exp2f(-2.0f * LOG2E * u);
    const float th = (1.0f - e) / (1.0f + e);
    return 0.5f * x * (1.0f + th);
}
DI int ltid() { int t = threadIdx.x; asm volatile("" : "+v"(t)); return t; }
DI int crow(int reg, int h) { return (reg & 3) + 8 * (reg >> 2) + 4 * h; }
DI int t5_bucket(int d) {
    if (d < 16) return d;
    int b = 16;
    b += (d >= 19); b += (d >= 21); b += (d >= 24); b += (d >= 27); b += (d >= 31); b += (d >= 35); b += (d >= 40); b += (d >= 46);
    b += (d >= 52); b += (d >= 59); b += (d >= 67); b += (d >= 77); b += (d >= 87); b += (d >= 99); b += (d >= 113);
    return b;
}
DI int perm_in(int n) {
    if (n < 896) return n;
    if (n < 1024) return 2304 + (n - 896);
    if (n < 1152) return 896 + (n - 1024);
    if (n < 1280) return 2432 + (n - 1152);
    if (n < 1304) return 2048 + (n - 1280);
    if (n < 1816) return 1024 + (n - 1304);
    if (n < 2328) return 1536 + (n - 1816);
    return 2560 + (n - 2328);
}

DI void transpose_unit(char* smem, const float* __restrict__ W, int K, int N, bf16_t* __restrict__ Wt, int kb, int nb, int mode) {
    float* tile = (float*)smem;
    const int tid = ltid();
#pragma unroll
    for (int it = 0; it < 8; ++it) {
        const int i = (tid >> 6) + 8 * it, j = tid & 63, n = nb * 64 + j;
        tile[i * 65 + j] = (n < N) ? W[(size_t)(kb * 64 + i) * N + n] : 0.f;
    }
    __syncthreads();
    {
        const int j = tid >> 3, kc = tid & 7, n = nb * 64 + j;
        if (n < N) {
            const int np = mode == 1 ? perm_in(n) : n;
            u32x4 o;
            o.x = pk2(tile[(kc * 8 + 0) * 65 + j], tile[(kc * 8 + 1) * 65 + j]);
            o.y = pk2(tile[(kc * 8 + 2) * 65 + j], tile[(kc * 8 + 3) * 65 + j]);
            o.z = pk2(tile[(kc * 8 + 4) * 65 + j], tile[(kc * 8 + 5) * 65 + j]);
            o.w = pk2(tile[(kc * 8 + 6) * 65 + j], tile[(kc * 8 + 7) * 65 + j]);
            *(u32x4*)(Wt + (size_t)np * K + kb * 64 + kc * 8) = o;
        }
    }
    __syncthreads();
}

DI void mod_unit(char* smem, const Params& P, int u) {
    float* cond = (float*)smem;
    const int tid = ltid();
    for (int i = tid; i < NB * DM; i += NTHREADS) {
        const int b = i >> 10, k = i & 1023;
        const float cv = P.c[i];
        cond[k * 16 + b] = cv / (1.0f + __expf(-cv));
    }
    __syncthreads();
    const int col = u * NTHREADS + tid;
    float acc[16];
#pragma unroll
    for (int b = 0; b < 16; ++b) acc[b] = 0.f;
    const float* wp = P.ada_w + col;
    for (int k0 = 0; k0 < DM; k0 += 16) {
        float wv[16];
#pragma unroll
        for (int i = 0; i < 16; ++i) wv[i] = wp[(size_t)(k0 + i) * 6144];
#pragma unroll
        for (int i = 0; i < 16; ++i) {
        const int k = k0 + i;
        const float w = wv[i];
        const f32x4 c0 = *(const f32x4*)(cond + k * 16), c1 = *(const f32x4*)(cond + k * 16 + 4), c2 = *(const f32x4*)(cond + k * 16 + 8), c3 = *(const f32x4*)(cond + k * 16 + 12);
        acc[0] += w * c0.x; acc[1] += w * c0.y; acc[2] += w * c0.z; acc[3] += w * c0.w;
        acc[4] += w * c1.x; acc[5] += w * c1.y; acc[6] += w * c1.z; acc[7] += w * c1.w;
        acc[8] += w * c2.x; acc[9] += w * c2.y; acc[10] += w * c2.z; acc[11] += w * c2.w;
        acc[12] += w * c3.x; acc[13] += w * c3.y; acc[14] += w * c3.z; acc[15] += w * c3.w;
        }
    }
    float* mod = (float*)(P.ws + OFF_MOD);
    const float bias = P.ada_b[col];
#pragma unroll
    for (int b = 0; b < 16; ++b) mod[(size_t)b * 6144 + col] = acc[b] + bias;
    __syncthreads();
}

DI void misc_unit(const Params& P) {
    const int tid = ltid();
    float* tab = (float*)(P.ws + OFF_TAB);
    for (int i = tid; i < 12 * 128; i += NTHREADS) {
        const int hd = i >> 7, d = i & 127;
        tab[i] = (P.rel_bias[t5_bucket(d) * 12 + hd] - P.rel_bias[31 * 12 + hd]) * LOG2E;
    }
    bf16_t* sk = (bf16_t*)(P.ws + OFF_SK);
    for (int i = tid; i < 2 * 128 * 128 / 2; i += NTHREADS) ((unsigned*)sk)[i] = pk2(P.peer_sub[2 * i], P.peer_sub[2 * i + 1]);
    unsigned* wz = (unsigned*)((bf16_t*)(P.ws + OFF_WINT) + (size_t)2072 * 1024);
    for (int i = tid; i < 232 * 1024 / 2; i += NTHREADS) wz[i] = 0u;
    for (int kv = 0; kv < 2; ++kv) {
        unsigned* z2 = (unsigned*)((bf16_t*)(P.ws + OFF_W2T) + (size_t)(kv * 128 + 64) * 256);
        for (int i = tid; i < 64 * 256 / 2; i += NTHREADS) z2[i] = 0u;
    }
}

DI void pb_unit(char* smem, const Params& P, int u) {
    const int tid = ltid(), o = u * 64 + (tid & 63), kp = tid >> 6;
    const int kv = o >> 8, n = o & 255;
    const float* pos = P.cmp_pos + kv * 2048 + kp * 256;
    const float* w1 = P.cmp_w1 + (size_t)kv * 2048 * 256 + (size_t)kp * 256 * 256 + n;
    float a = 0.f;
    for (int k0 = 0; k0 < 256; k0 += 16) {
        float wv[16];
#pragma unroll
        for (int i = 0; i < 16; ++i) wv[i] = w1[(size_t)(k0 + i) * 256];
#pragma unroll
        for (int i = 0; i < 16; ++i) a += pos[k0 + i] * wv[i];
    }
    float* red = (float*)smem;
    __syncthreads();
    red[kp * 64 + (tid & 63)] = a;
    __syncthreads();
    if (tid < 64) {
        float t = 0.f;
#pragma unroll
        for (int q = 0; q < 8; ++q) t += red[q * 64 + tid];
        ((float*)(P.ws + OFF_PB))[o] = t;
    }
    __syncthreads();
}

template <int PART>
DI void phase_prologue(const Params& P, char* smem, int bidv, int Gv) {
    const int tid = ltid(), G = Gv, bid = bidv;
    if (PART != 0) {
        const int lane = tid & 63, wid = tid >> 6;
        for (int rw0 = (bid * 8 + wid) * 4; rw0 < 2 * 16384; rw0 += G * 8 * 4) {
            f32x4 v[4][4];
#pragma unroll
            for (int q = 0; q < 4; ++q) {
                const int rw = rw0 + q, tb = rw >> 14, e = rw & 16383;
                const float* src = (tb ? P.peer_v : P.peer_u) + (size_t)e * DM + 16 * lane;
#pragma unroll
                for (int j = 0; j < 4; ++j) v[q][j] = *(const f32x4*)(src + 4 * j);
            }
#pragma unroll
            for (int q = 0; q < 4; ++q) {
                const int rw = rw0 + q, tb = rw >> 14, e = rw & 16383;
                float am = 0.f;
#pragma unroll
                for (int j = 0; j < 4; ++j) am = fmaxf(am, fmaxf(fmaxf(fabsf(v[q][j].x), fabsf(v[q][j].y)), fmaxf(fabsf(v[q][j].z), fabsf(v[q][j].w))));
#pragma unroll
                for (int o = 1; o < 64; o <<= 1) am = fmaxf(am, __shfl_xor(am, o));
                const float sc = am > 0.f ? am * (1.0f / 127.0f) : 1.0f, inv = 1.0f / sc;
                u32x4 o4;
#pragma unroll
                for (int j = 0; j < 4; ++j) {
                    const int q0 = (int)rintf(v[q][j].x * inv) + 128, q1 = (int)rintf(v[q][j].y * inv) + 128, q2 = (int)rintf(v[q][j].z * inv) + 128, q3 = (int)rintf(v[q][j].w * inv) + 128;
                    const unsigned w = (unsigned)(q0 < 0 ? 0 : (q0 > 255 ? 255 : q0)) | ((unsigned)(q1 < 0 ? 0 : (q1 > 255 ? 255 : q1)) << 8) |
                                       ((unsigned)(q2 < 0 ? 0 : (q2 > 255 ? 255 : q2)) << 16) | ((unsigned)(q3 < 0 ? 0 : (q3 > 255 ? 255 : q3)) << 24);
                    if (j == 0) o4.x = w; else if (j == 1) o4.y = w; else if (j == 2) o4.z = w; else o4.w = w;
                }
                unsigned char* dst = P.ws + (tb ? OFF_V : OFF_U);
                *(u32x4*)(dst + (size_t)e * DM + 16 * lane) = o4;
                if (lane == 0) ((float*)(P.ws + (tb ? OFF_VS : OFF_US)))[e] = sc;
            }
        }
    }
    constexpr int U_MOD = 12, U_MISC = 1, U_PB = 8;
    constexpr int U_WIN = 16 * 45, U_WOUT = 16 * 16, U_WQ = 16 * 32, U_W1 = 2 * 32 * 4, U_W2 = 2 * 4 * 1;
    constexpr int U_TOT = U_MOD + U_MISC + U_PB + U_WIN + U_WOUT + U_WQ + U_W1 + U_W2;
    for (int u = bid; u < U_TOT; u += G) {
        int r = u;
        constexpr bool EARLY = PART != 1, LATE = PART != 0;
        if (r < U_MOD) { if (EARLY) mod_unit(smem, P, r); continue; } r -= U_MOD;
        if (r < U_MISC) { if (EARLY) misc_unit(P); continue; } r -= U_MISC;
        if (r < U_PB) { if (EARLY) pb_unit(smem, P, r); continue; } r -= U_PB;
        if (r < U_WIN) { if (EARLY) transpose_unit(smem, P.w_in, 1024, 2840, (bf16_t*)(P.ws + OFF_WINT), r / 45, r % 45, 1); continue; } r -= U_WIN;
        if (r < U_WOUT) { if (LATE) transpose_unit(smem, P.w_out, 1024, 1024, (bf16_t*)(P.ws + OFF_WOUTT), r / 16, r % 16, 0); continue; } r -= U_WOUT;
        if (r < U_WQ) { if (LATE) transpose_unit(smem, P.peer_wq, 1024, 2048, (bf16_t*)(P.ws + OFF_WQT), r / 32, r % 32, 0); continue; } r -= U_WQ;
        if (r < U_W1) { if (EARLY) { const int kv = r / 128, q = r % 128; transpose_unit(smem, P.cmp_w1 + (size_t)kv * 2048 * 256, 2048, 256, (bf16_t*)(P.ws + OFF_W1T) + (size_t)kv * 256 * 2048, q / 4, q % 4, 0); } continue; } r -= U_W1;
        if (EARLY) { const int kv = r / 4, q = r % 4; transpose_unit(smem, P.cmp_w2 + (size_t)kv * 256 * 64, 256, 64, (bf16_t*)(P.ws + OFF_W2T) + (size_t)kv * 128 * 256, q, 0, 0); }
    }
}

template <bool BF16IN>
DI void phase_normmod(const Params& P, const void* __restrict__ xin_, const float* __restrict__ gvec, int sh_idx, int sc_idx, bf16_t* __restrict__ outp,
                      int row0 = 0, int row1 = NTOK, int bi = blockIdx.x, int nb = gridDim.x) {
    const int tid = ltid(), lane = tid & 63, wid = tid >> 6;
    const float* mod = (const float*)(P.ws + OFF_MOD);
    const int gw = bi * 8 + wid, NGW = nb * 8;
    for (int row = row0 + gw; row < row1; row += NGW) {
        const int b = row >> 12;
        f32x4 v[4]; float ss = 0.f;
        if (BF16IN) {
            const u32x2* xr = (const u32x2*)((const bf16_t*)xin_ + (size_t)row * DM) + lane;
#pragma unroll
            for (int j = 0; j < 4; ++j) { const u32x2 w = xr[64 * j]; v[j] = (f32x4){bf_lo(w.x), bf_hi(w.x), bf_lo(w.y), bf_hi(w.y)}; }
        } else {
            const f32x4* xr = (const f32x4*)((const float*)xin_ + (size_t)row * DM) + lane;
#pragma unroll
            for (int j = 0; j < 4; ++j) v[j] = xr[64 * j];
        }
#pragma unroll
        for (int j = 0; j < 4; ++j) ss += (v[j].x * v[j].x + v[j].y * v[j].y) + (v[j].z * v[j].z + v[j].w * v[j].w);
        const float rstd = __builtin_amdgcn_rsqf(wave_sum(ss) * (1.0f / DM) + RMS_EPS);
        const float* shp = mod + (size_t)b * 6144 + sh_idx * 1024;
        const float* scp = mod + (size_t)b * 6144 + sc_idx * 1024;
        u32x2* o8 = (u32x2*)(outp + (size_t)row * DM) + lane;
#pragma unroll
        for (int j = 0; j < 4; ++j) {
            const int col = 4 * lane + 256 * j;
            const f32x4 g = *(const f32x4*)(gvec + col), sc = *(const f32x4*)(scp + col), sh = *(const f32x4*)(shp + col);
            const float a0 = v[j].x * rstd * g.x * (1.f + sc.x) + sh.x, a1 = v[j].y * rstd * g.y * (1.f + sc.y) + sh.y;
            const float a2 = v[j].z * rstd * g.z * (1.f + sc.z) + sh.z, a3 = v[j].w * rstd * g.w * (1.f + sc.w) + sh.w;
            u32x2 w; w.x = pk2(a0, a1); w.y = pk2(a2, a3);
            o8[64 * j] = w;
        }
    }
}

constexpr int G_STAGE = 49152;
struct ARowMajor {
    const bf16_t* A; int lda;
    DI const bf16_t* operator()(int m, int kt) const { return A + (size_t)m * lda + kt * 64; }
};
struct ACmp {
    const bf16_t* src;
    DI const bf16_t* operator()(int m, int kt) const {
        const int bg = m >> 8; int c = m & 255; c = c > 254 ? 254 : c;
        return src + ((size_t)((bg >> 1) * SEQ + 16 * c + kt)) * 128 + (bg & 1) * 64;
    }
};

template <bool TRANS, class AF, class Epi>
DI void gemm_tile(char* smem, const AF& af, const bf16_t* __restrict__ Bt, int ldb, int m0, int n0, int nk, const Epi& epi) {
    const int tid = ltid(), lane = tid & 63, wid = tid >> 6, wr = wid >> 1, wc = wid & 1, fr = lane & 15, fq = lane >> 4;
    const int lrow = tid >> 3, lc = tid & 7;
    const int ldsoff = lrow * 128 + ((lc ^ ((tid >> 4) & 7)) << 4);
    const bf16_t* ap[4]; const bf16_t* bp[2];
#pragma unroll
    for (int i = 0; i < 4; ++i) ap[i] = af(m0 + lrow + 64 * i, 0) + lc * 8;
#pragma unroll
    for (int i = 0; i < 2; ++i) bp[i] = Bt + (size_t)(n0 + lrow + 64 * i) * ldb + lc * 8;
    const int astep = (int)(af(m0, 1) - af(m0, 0));
    f32x4 acc[4][4];
#pragma unroll
    for (int i = 0; i < 4; ++i)
#pragma unroll
        for (int j = 0; j < 4; ++j) acc[i][j] = (f32x4){0.f, 0.f, 0.f, 0.f};
    u32x4 ra[4], rb[2];
#pragma unroll
    for (int i = 0; i < 4; ++i) ra[i] = *(const u32x4*)(ap[i]);
#pragma unroll
    for (int i = 0; i < 2; ++i) rb[i] = *(const u32x4*)(bp[i]);
    __syncthreads();
#pragma unroll
    for (int i = 0; i < 4; ++i) *(u32x4*)(smem + ldsoff + i * 8192) = ra[i];
#pragma unroll
    for (int i = 0; i < 2; ++i) *(u32x4*)(smem + 32768 + ldsoff + i * 8192) = rb[i];
    __syncthreads();
    const int sws = fr >> 1;
    const int aoff = (64 * wr + fr) * 128, boff = 32768 + (64 * wc + fr) * 128;
    for (int kt = 0; kt < nk; ++kt) {
        const int st = kt & 1;
        if (kt + 1 < nk) {
#pragma unroll
            for (int i = 0; i < 4; ++i) ra[i] = *(const u32x4*)(ap[i] + (size_t)(kt + 1) * astep);
#pragma unroll
            for (int i = 0; i < 2; ++i) rb[i] = *(const u32x4*)(bp[i] + (kt + 1) * 64);
        }
        const char* sb = smem + st * G_STAGE;
#pragma unroll
        for (int kk = 0; kk < 2; ++kk) {
            const int cho = ((kk * 4 + fq) ^ sws) << 4;
            bf16x8 afr[4], bfr[4];
#pragma unroll
            for (int i = 0; i < 4; ++i) afr[i] = *(const bf16x8*)(sb + aoff + i * 2048 + cho);
#pragma unroll
            for (int j = 0; j < 4; ++j) bfr[j] = *(const bf16x8*)(sb + boff + j * 2048 + cho);
#pragma unroll
            for (int i = 0; i < 4; ++i)
#pragma unroll
                for (int j = 0; j < 4; ++j)
                    acc[i][j] = TRANS ? MFMA16(afr[i], bfr[j], acc[i][j]) : MFMA16(bfr[j], afr[i], acc[i][j]);
        }
        if (kt + 1 < nk) {
            char* sn = smem + (st ^ 1) * G_STAGE;
#pragma unroll
            for (int i = 0; i < 4; ++i) *(u32x4*)(sn + ldsoff + i * 8192) = ra[i];
#pragma unroll
            for (int i = 0; i < 2; ++i) *(u32x4*)(sn + 32768 + ldsoff + i * 8192) = rb[i];
        }
        __syncthreads();
    }
#pragma unroll
    for (int i = 0; i < 4; ++i)
#pragma unroll
        for (int j = 0; j < 4; ++j) {
            if (TRANS) epi.tr(m0 + 64 * wr + 16 * i + 4 * fq, n0 + 64 * wc + 16 * j + fr, acc[i][j]);
            else epi.nt(m0 + 64 * wr + 16 * i + fr, n0 + 64 * wc + 16 * j + 4 * fq, acc[i][j]);
        }
}

DI void st_bf8(bf16_t* p, f32x4 a, f32x4 b, float s) { u32x4 w; w.x = pk2(a.x * s, a.y * s); w.y = pk2(a.z * s, a.w * s); w.z = pk2(b.x * s, b.y * s); w.w = pk2(b.z * s, b.w * s); *(u32x4*)p = w; }
DI void st_bf4(bf16_t* p, f32x4 v, float s) { u32x2 w; w.x = pk2(v.x * s, v.y * s); w.y = pk2(v.z * s, v.w * s); *(u32x2*)p = w; }

struct EpiInProj {
    unsigned char* ws;
    DI void nt8(int m, int n, f32x4 v0, f32x4 v1) const {
        if (n < 512) st_bf8((bf16_t*)(ws + OFF_QN) + (size_t)m * 512 + n, v0, v1, QSCALE);
        else if (n < 640) st_bf8((bf16_t*)(ws + OFF_KC) + (size_t)m * 128 + (n - 512), v0, v1, 1.f);
        else if (n < 768) st_bf8((bf16_t*)(ws + OFF_VC) + (size_t)m * 128 + (n - 640), v0, v1, 1.f);
        else if (n < 896) st_bf8((bf16_t*)(ws + OFF_KS) + (size_t)m * 128 + (n - 768), v0, v1, 1.f);
        else if (n < 1024) st_bf8((bf16_t*)(ws + OFF_KW) + (size_t)m * 128 + (n - 896), v0, v1, 1.f);
        else if (n < 1536) st_bf8((bf16_t*)(ws + OFF_DQ) + (size_t)m * 512 + (n - 1024), v0, v1, QSCALE);
        else if (n < 2048) st_bf8((bf16_t*)(ws + OFF_DK) + (size_t)m * 512 + (n - 1536), v0, v1, 1.f);
        else if (n < 2072) {
            float* gp = (float*)(ws + OFF_GATES) + (size_t)m * 24 + (n - 2048);
            f32x4 o0, o1;
            o0.x = 1.f / (1.f + __expf(-v0.x)); o0.y = 1.f / (1.f + __expf(-v0.y)); o0.z = 1.f / (1.f + __expf(-v0.z)); o0.w = 1.f / (1.f + __expf(-v0.w));
            o1.x = 1.f / (1.f + __expf(-v1.x)); o1.y = 1.f / (1.f + __expf(-v1.y)); o1.z = 1.f / (1.f + __expf(-v1.z)); o1.w = 1.f / (1.f + __expf(-v1.w));
            *(f32x4*)gp = o0; *(f32x4*)(gp + 4) = o1;
        }
    }
};
struct EpiInProjT {
    unsigned char* ws;
    DI void nt8(int vr, int t, f32x4 v0, f32x4 v1) const {
        const int b = t >> 12, sq = t & 4095;
        bf16_t* dst;
        if (vr < 128) dst = (bf16_t*)(ws + OFF_VST) + ((size_t)(b * 128 + vr)) * SEQ + sq;
        else if (vr < 256) dst = (bf16_t*)(ws + OFF_VWT) + ((size_t)(b * 128 + (vr - 128))) * SEQ + sq;
        else dst = (bf16_t*)(ws + OFF_DVT) + ((size_t)(b * 512 + (vr - 256))) * SEQ + sq;
        st_bf8(dst, v0, v1, 1.f);
    }
};
DI bool inproj_tile_is_trans(int) { return false; }

struct EpiCmp1 {
    bf16_t* hid; const float* pb;
    DI void nt(int m, int n, f32x4 v) const {
        const f32x4 p = *(const f32x4*)(pb + n);
        u32x2 w; w.x = pk2(gelu_tanh(v.x + p.x), gelu_tanh(v.y + p.y)); w.y = pk2(gelu_tanh(v.z + p.z), gelu_tanh(v.w + p.w));
        *(u32x2*)(hid + (size_t)m * 256 + n) = w;
    }
    DI void tr(int, int, f32x4) const {}
};
struct EpiCmp2 {
    bf16_t* kc; bf16_t* vt;
    DI void nt(int m, int n, f32x4 v) const { if (n < 64) st_bf4(kc + (size_t)m * 64 + n, v, 1.f); }
    DI void tr(int m, int n, f32x4 v) const { if (n < 64) st_bf4(vt + ((size_t)((m >> 8) * 64 + n)) * 256 + (m & 255), v, 1.f); }
};
struct EpiOutProj {
    const float* x; const float* mod; bf16_t* x1;
    DI void nt(int m, int n, f32x4 v) const {
        const int b = m >> 12;
        const f32x4 g = *(const f32x4*)(mod + (size_t)b * 6144 + 2 * 1024 + n);
        const f32x4 xv = *(const f32x4*)(x + (size_t)m * DM + n);
        f32x4 o; o.x = xv.x + g.x * v.x; o.y = xv.y + g.y * v.y; o.z = xv.z + g.z * v.z; o.w = xv.w + g.w * v.w;
        st_bf4(x1 + (size_t)m * DM + n, o, 1.f);
    }
    DI void nt8(int m, int n, f32x4 v0, f32x4 v1) const {
        const int b = m >> 12;
        const float* gp = mod + (size_t)b * 6144 + 2 * 1024 + n; const float* xp = x + (size_t)m * DM + n;
        const f32x4 g0 = *(const f32x4*)gp, g1 = *(const f32x4*)(gp + 4), x0 = *(const f32x4*)xp, xq = *(const f32x4*)(xp + 4);
        f32x4 o0, o1;
        o0.x = x0.x + g0.x * v0.x; o0.y = x0.y + g0.y * v0.y; o0.z = x0.z + g0.z * v0.z; o0.w = x0.w + g0.w * v0.w;
        o1.x = xq.x + g1.x * v1.x; o1.y = xq.y + g1.y * v1.y; o1.z = xq.z + g1.z * v1.z; o1.w = xq.w + g1.w * v1.w;
        st_bf8(x1 + (size_t)m * DM + n, o0, o1, 1.f);
    }
    DI void tr(int, int, f32x4) const {}
};
struct EpiWq {
    bf16_t* qp;
    DI void nt8(int m, int n, f32x4 v0, f32x4 v1) const {
        const int d = n & 127;
        bf16_t* dst = qp + ((size_t)(m >> 5) * 16 + (n >> 7)) * 4096 + (size_t)((d >> 3) * 32 + (m & 31)) * 8;
        st_bf8(dst, v0, v1, 1.f);
    }
    DI void nt(int, int, f32x4) const {}
    DI void tr(int, int, f32x4) const {}
};

namespace pg8 {
#define PG8_LAS __attribute__((address_space(3)))
typedef unsigned short bf16_t;
typedef short bf16x8 __attribute__((ext_vector_type(8)));
typedef float f32x4 __attribute__((ext_vector_type(4)));
typedef unsigned u32x4 __attribute__((ext_vector_type(4)));
constexpr int BM = 256, BK = 64, HALF = 128, HTB = HALF * BK * 2  , STAGE_BYTES = 8 * HTB, NXCD = 8, WGM = 8;

__host__ __device__ __forceinline__ int lds_byte(int r, int c) { const int st = (r >> 4) * 2 + (c >> 5), rr = r & 15, cc = c & 31, ob = rr * 64 + cc * 2; return st * 1024 + (ob ^ (((ob >> 9) & 1) << 5)); }
__host__ __device__ __forceinline__ void stage_rc(int b, int& R, int& C) { const int st = b / 1024, sb = b % 1024, swz = sb ^ (((sb >> 9) & 1) << 5); R = (st >> 1) * 16 + swz / 64; C = (st & 1) * 32 + (swz % 64) / 2; }
__host__ __device__ __forceinline__ int perm32(int rho) { const int n = rho >> 4, i = rho & 15; return 8 * (i >> 2) + 4 * n + (i & 3); }

struct Unit { int pm, pn; };
struct Gemm { const bf16_t* A; const bf16_t* Bt; int M, N, K; };

struct StaticOrder {
    int nM, nN, nwg, G, c;
    __host__ __device__ void init(int M, int N, int G_, int c_) { nM = M / BM; nN = N / BM; nwg = nM * nN; G = G_; c = c_; }
    __host__ __device__ bool next(int i, Unit& u) const {
        const long L = (long)i * G + c; if (L >= nwg) return false;
        int wgid = (int)L; { const int q = nwg / NXCD, r = nwg % NXCD, xcd = wgid % NXCD, off = wgid / NXCD; wgid = (xcd < r ? xcd * (q + 1) : r * (q + 1) + (xcd - r) * q) + off; }
        const int nig = WGM * nN, gid = wgid / nig, fm = gid * WGM, gsz = (nM - fm) < WGM ? (nM - fm) : WGM;
        u.pm = fm + ((wgid % nig) % gsz); u.pn = (wgid % nig) / gsz; return true;
    }
    __device__ __forceinline__ void a_ready(const Unit&) const {}
    __device__ __forceinline__ void done(const Unit&) const {}
};


template <class Epi, class Sched, bool ALIGN_EPI = false, bool SP2 = false>
__device__ __forceinline__ void gemm_phase(PG8_LAS unsigned char* lds, const Gemm g, const Sched& S, const Epi& E) {
    const int tid = ltid(), wid = __builtin_amdgcn_readfirstlane(tid >> 6), lane = tid & 63, wr = wid >> 2, wc = wid & 3, fr = lane & 15, fq = lane >> 4;
    const int K = g.K, nt = K / BK;
    unsigned voffA[2], voffB[2];
#pragma unroll
    for (int i = 0; i < 2; ++i) { int R, C; stage_rc(tid * 16 + i * 8192, R, C); const int Rb = Epi::PERM ? ((R & ~31) + perm32(R & 31)) : R;
        voffA[i] = (unsigned)(R * K + C) * 2u; voffB[i] = (unsigned)(Rb * K + C) * 2u; }
    const size_t kstep = (size_t)(BK * 2);
    const size_t hstep = (size_t)HALF * K * 2;
    const size_t tstep = 2 * hstep;
    const unsigned ldsw = (unsigned)wid * 1024u;
    const int aoff = lds_byte(wr * 64 + fr, fq * 8), boff = lds_byte(wc * 32 + fr, fq * 8);
#define PG8_SA(b, h) (((b) * 2 + (h)) * HTB)
#define PG8_SB(b, h) ((4 + (b) * 2 + (h)) * HTB)
#define PG8_STAGE(bufoff, gbase, voff) do { _Pragma("unroll") for (int _i = 0; _i < 2; ++_i) \
        __builtin_amdgcn_global_load_lds((const unsigned*)((const char*)(gbase) + (voff)[_i]), (PG8_LAS unsigned*)(lds + (bufoff) + ldsw + _i * 8192), 16, 0, 0); } while (0)
#define PG8_LDA(dst, b, h) do { _Pragma("unroll") for (int m = 0; m < 4; ++m) _Pragma("unroll") for (int k = 0; k < 2; ++k) dst[m][k] = *(const PG8_LAS bf16x8*)(lds + PG8_SA(b, h) + aoff + m * 2048 + k * 1024); } while (0)
#define PG8_LDB(dst, b, h) do { _Pragma("unroll") for (int n = 0; n < 2; ++n) _Pragma("unroll") for (int k = 0; k < 2; ++k) dst[n][k] = *(const PG8_LAS bf16x8*)(lds + PG8_SB(b, h) + boff + n * 2048 + k * 1024); } while (0)
#define PG8_MMA(ai, bj, At, Bt) do { __builtin_amdgcn_s_setprio(1); _Pragma("unroll") for (int m = 0; m < 4; ++m) _Pragma("unroll") for (int n = 0; n < 2; ++n) _Pragma("unroll") for (int k = 0; k < 2; ++k) \
        acc[ai][bj][m][n] = __builtin_amdgcn_mfma_f32_16x16x32_bf16(Bt[n][k], At[m][k], acc[ai][bj][m][n], 0, 0, 0); __builtin_amdgcn_s_setprio(0); } while (0)
#define PG8_WAIT_V(n) asm volatile("s_waitcnt vmcnt(" #n ")" ::: "memory")
#define PG8_WAIT_L(n) asm volatile("s_waitcnt lgkmcnt(" #n ")" ::: "memory")
#define PG8_BAR __builtin_amdgcn_s_barrier()
#define PG8_SCHED __builtin_amdgcn_sched_barrier(0)
    Unit cur, nxt; int ui = 0;
    if (!S.next(0, cur)) return;
    f32x4 acc[2][2][4][2];
#pragma unroll
    for (int a = 0; a < 2; ++a)
#pragma unroll
        for (int b = 0; b < 2; ++b)
#pragma unroll
            for (int m = 0; m < 4; ++m)
#pragma unroll
                for (int n = 0; n < 2; ++n) acc[a][b][m][n] = (f32x4){0.f, 0.f, 0.f, 0.f};
    bf16x8 At[4][2], B0[2][2], B1[2][2];
    const char* cA = (const char*)g.A + (size_t)cur.pm * tstep; const char* cB = (const char*)g.Bt + (size_t)cur.pn * tstep;
    S.a_ready(cur);
    if constexpr (SP2) {
        PG8_STAGE(PG8_SB(0, 0), cB, voffB); PG8_STAGE(PG8_SB(0, 1), cB + hstep, voffB); PG8_STAGE(PG8_SA(0, 0), cA, voffA); PG8_STAGE(PG8_SA(0, 1), cA + hstep, voffA);
        if (wr == 1) PG8_BAR;
        PG8_WAIT_V(2); PG8_BAR;
        PG8_STAGE(PG8_SB(1, 0), cB + kstep, voffB); PG8_STAGE(PG8_SA(1, 0), cA + kstep, voffA); PG8_STAGE(PG8_SB(1, 1), cB + hstep + kstep, voffB);
        PG8_WAIT_V(6); PG8_BAR;
    } else {
        PG8_STAGE(PG8_SB(0, 0), cB, voffB); PG8_STAGE(PG8_SA(0, 0), cA, voffA); PG8_STAGE(PG8_SB(0, 1), cB + hstep, voffB); PG8_STAGE(PG8_SA(0, 1), cA + hstep, voffA);
        if (wr == 1) PG8_BAR;
        PG8_WAIT_V(4); PG8_BAR;
        PG8_STAGE(PG8_SB(1, 0), cB + kstep, voffB); PG8_STAGE(PG8_SA(1, 0), cA + kstep, voffA); PG8_STAGE(PG8_SB(1, 1), cB + hstep + kstep, voffB);
        PG8_WAIT_V(6); PG8_BAR;
    }
    for (;;) {
        const bool has_next = S.next(ui + 1, nxt);
        const char* nA = has_next ? (const char*)g.A + (size_t)nxt.pm * tstep : cA; const char* nB = has_next ? (const char*)g.Bt + (size_t)nxt.pn * tstep : cB;
        for (int t = 0; t < nt; t += 2) {
            const bool last = (t == nt - 2);
            const char* a1 = cA + (size_t)(t + 1) * kstep;
            const char* a2 = last ? nA : cA + (size_t)(t + 2) * kstep; const char* b2 = last ? nB : cB + (size_t)(t + 2) * kstep;
            const char* a3 = a2 + kstep; const char* b3 = b2 + kstep;
            if (last && has_next) S.a_ready(nxt);
            if constexpr (SP2) {
            PG8_LDB(B0, 0, 0); PG8_LDB(B1, 0, 1); PG8_SCHED; PG8_LDA(At, 0, 0); PG8_STAGE(PG8_SA(1, 1), a1 + hstep, voffA);
            PG8_WAIT_V(8); PG8_WAIT_L(0); PG8_BAR; PG8_MMA(0, 0, At, B0); PG8_MMA(0, 1, At, B1); PG8_BAR; PG8_SCHED;
            PG8_LDA(At, 0, 1); PG8_STAGE(PG8_SB(0, 0), b2, voffB); PG8_STAGE(PG8_SB(0, 1), b2 + hstep, voffB); PG8_STAGE(PG8_SA(0, 0), a2, voffA);
            PG8_WAIT_V(8); PG8_WAIT_L(0); PG8_BAR; PG8_MMA(1, 0, At, B0); PG8_MMA(1, 1, At, B1); PG8_BAR; PG8_SCHED;
            PG8_LDB(B0, 1, 0); PG8_LDB(B1, 1, 1); PG8_SCHED; PG8_LDA(At, 1, 0); PG8_STAGE(PG8_SA(0, 1), a2 + hstep, voffA);
            PG8_WAIT_V(8); PG8_WAIT_L(0); PG8_BAR; PG8_MMA(0, 0, At, B0); PG8_MMA(0, 1, At, B1); PG8_BAR; PG8_SCHED;
            PG8_LDA(At, 1, 1); PG8_STAGE(PG8_SB(1, 0), b3, voffB); PG8_STAGE(PG8_SB(1, 1), b3 + hstep, voffB); PG8_STAGE(PG8_SA(1, 0), a3, voffA);
            PG8_WAIT_V(8); PG8_WAIT_L(0); PG8_BAR; PG8_MMA(1, 0, At, B0); PG8_MMA(1, 1, At, B1); PG8_BAR; PG8_SCHED;
            } else {
            PG8_LDB(B0, 0, 0); PG8_SCHED; PG8_LDA(At, 0, 0); PG8_STAGE(PG8_SA(1, 1), a1 + hstep, voffA);
            PG8_WAIT_L(8); PG8_BAR; PG8_WAIT_L(0); PG8_MMA(0, 0, At, B0); PG8_BAR; PG8_SCHED;
            PG8_LDB(B1, 0, 1); PG8_STAGE(PG8_SB(0, 0), b2, voffB);
            PG8_BAR; PG8_WAIT_L(0); PG8_MMA(0, 1, At, B1); PG8_BAR;
            PG8_LDA(At, 0, 1); PG8_STAGE(PG8_SA(0, 0), a2, voffA);
            PG8_BAR; PG8_WAIT_L(0); PG8_MMA(1, 0, At, B0); PG8_BAR; PG8_SCHED;
            PG8_STAGE(PG8_SB(0, 1), b2 + hstep, voffB);
            PG8_WAIT_V(6); PG8_BAR; PG8_MMA(1, 1, At, B1); PG8_BAR;
            PG8_LDB(B0, 1, 0); PG8_SCHED; PG8_LDA(At, 1, 0); PG8_STAGE(PG8_SA(0, 1), a2 + hstep, voffA);
            PG8_WAIT_L(8); PG8_BAR; PG8_WAIT_L(0); PG8_MMA(0, 0, At, B0); PG8_BAR; PG8_SCHED;
            PG8_LDB(B1, 1, 1); PG8_STAGE(PG8_SB(1, 0), b3, voffB);
            PG8_BAR; PG8_WAIT_L(0); PG8_MMA(0, 1, At, B1); PG8_BAR;
            PG8_LDA(At, 1, 1); PG8_STAGE(PG8_SA(1, 0), a3, voffA);
            PG8_BAR; PG8_WAIT_L(0); PG8_MMA(1, 0, At, B0); PG8_BAR; PG8_SCHED;
            PG8_STAGE(PG8_SB(1, 1), b3 + hstep, voffB);
            PG8_WAIT_V(6); PG8_BAR; PG8_MMA(1, 1, At, B1); PG8_BAR;
            }
        }
        if constexpr (ALIGN_EPI) { if (wr == 0) PG8_BAR; }
        if constexpr (!Epi::AFTER_DRAIN) { E(acc, cur, wr, wc, fr, fq); S.done(cur); }
        if (!has_next) break;
#pragma unroll
        for (int a = 0; a < 2; ++a)
#pragma unroll
            for (int b = 0; b < 2; ++b)
#pragma unroll
                for (int m = 0; m < 4; ++m)
#pragma unroll
                    for (int n = 0; n < 2; ++n) acc[a][b][m][n] = (f32x4){0.f, 0.f, 0.f, 0.f};
        cur = nxt; cA = nA; cB = nB; ++ui;
        if constexpr (ALIGN_EPI) { if (wr == 1) PG8_BAR; }
    }
    PG8_WAIT_V(0);
    if constexpr (!ALIGN_EPI) { if (wr == 0) PG8_BAR; }
    PG8_BAR;
    if constexpr (Epi::AFTER_DRAIN) { E.fused(acc, cur, wr, wc, fr, fq, lds, wid, lane); S.done(cur); }
#undef PG8_SA
#undef PG8_SB
#undef PG8_STAGE
#undef PG8_LDA
#undef PG8_LDB
#undef PG8_MMA
#undef PG8_WAIT_V
#undef PG8_WAIT_L
#undef PG8_BAR
#undef PG8_SCHED
}
}


template <class F> struct EpiPg8 {
    static constexpr bool PERM = true, AFTER_DRAIN = false;
    F f;
    DI void operator()(const pg8::f32x4 (&acc)[2][2][4][2], const pg8::Unit& u, int wr, int wc, int fr, int fq) const {
#pragma unroll
        for (int ai = 0; ai < 2; ++ai)
#pragma unroll
            for (int m = 0; m < 4; ++m) {
                const int row = u.pm * 256 + 128 * ai + 64 * wr + 16 * m + fr;
#pragma unroll
                for (int bj = 0; bj < 2; ++bj) f.nt8(row, u.pn * 256 + 128 * bj + 32 * wc + 8 * fq, acc[ai][bj][m][0], acc[ai][bj][m][1]);
            }
    }
};

constexpr int VT_PITCH = 128;
DI int kperm(int rho) { return (rho & ~12) | ((rho & 4) << 1) | ((rho & 8) >> 1); }
DI int kidx(int reg, int h) { return (reg & 3) + 4 * ((reg >> 2) & 1) + 8 * h + 16 * (reg >> 3); }
#define LAS3 __attribute__((address_space(3)))
DI void glds16(const void* gsrc, char* lds_wave_base) { __builtin_amdgcn_global_load_lds((const unsigned*)gsrc, (LAS3 unsigned*)lds_wave_base, 16, 0, 0); }
constexpr float RESCALE_THR = 8.0f;

DI unsigned lds_addr(const char* p) { return (unsigned)(size_t)(LAS3 const char*)p; }
template <int OFF> DI bf16x8 ds128(unsigned a) { bf16x8 v; asm volatile("ds_read_b128 %0, %1 offset:%2" : "=v"(v) : "v"(a), "n"(OFF)); return v; }
#define MFMA_FENCE __builtin_amdgcn_sched_barrier(0)
#define LGKM_WAIT1(n, a) asm volatile("s_waitcnt lgkmcnt(" #n ")" : "+v"(a))
#define LGKM_WAIT2(n, a, b) asm volatile("s_waitcnt lgkmcnt(" #n ")" : "+v"(a), "+v"(b))
DI void qk_tile(const char* Ks, const bf16x8 (&qf)[4], int r, int h, const f32x16& cinit, f32x16& s0, f32x16& s1) {
    const int sw = (r >> 1) & 7;
    const unsigned kb = lds_addr(Ks) + r * 128;
    bf16x8 k0[4], k1[4];
#pragma unroll
    for (int ks = 0; ks < 4; ++ks) {
        const unsigned ka = kb + (((2 * ks + h) ^ sw) << 4);
        k0[ks] = ds128<0>(ka);
        k1[ks] = ds128<4096>(ka);
    }
    LGKM_WAIT2(6, k0[0], k1[0]);
    s0 = MFMA32(k0[0], qf[0], cinit); s1 = MFMA32(k1[0], qf[0], cinit);
    MFMA_FENCE;
    LGKM_WAIT2(4, k0[1], k1[1]);
    s0 = MFMA32(k0[1], qf[1], s0); s1 = MFMA32(k1[1], qf[1], s1);
    MFMA_FENCE;
    LGKM_WAIT2(2, k0[2], k1[2]);
    s0 = MFMA32(k0[2], qf[2], s0); s1 = MFMA32(k1[2], qf[2], s1);
    MFMA_FENCE;
    LGKM_WAIT2(0, k0[3], k1[3]);
    s0 = MFMA32(k0[3], qf[3], s0); s1 = MFMA32(k1[3], qf[3], s1);
    asm volatile("s_nop 15\n\ts_nop 7" : "+v"(s0), "+v"(s1));
}
DI void v_prefetch(const char* Vs, int r, int h, bf16x8 (&vf0)[4]) {
    const int sw = (r >> 1) & 7;
    const unsigned vb = lds_addr(Vs) + r * VT_PITCH;
#pragma unroll
    for (int st = 0; st < 4; ++st) vf0[st] = ds128<0>(vb + (((2 * st + h) ^ sw) << 4));
}
template <int NDT, int DT>
DI void pv_steps(const unsigned (&va)[4], bf16x8 (&cur)[4], const bf16x8 (&pf)[4], f32x16 (&o)[NDT]) {
    bf16x8 nxt[4];
    if constexpr (DT + 1 < NDT) {
#pragma unroll
        for (int st = 0; st < 4; ++st) nxt[st] = ds128<32 * VT_PITCH * (DT + 1)>(va[st]);
        LGKM_WAIT1(7, cur[0]); o[DT] = MFMA32(cur[0], pf[0], o[DT]);
        LGKM_WAIT1(6, cur[1]); o[DT] = MFMA32(cur[1], pf[1], o[DT]);
        LGKM_WAIT1(5, cur[2]); o[DT] = MFMA32(cur[2], pf[2], o[DT]);
        LGKM_WAIT1(4, cur[3]); o[DT] = MFMA32(cur[3], pf[3], o[DT]);
        MFMA_FENCE;
        pv_steps<NDT, DT + 1>(va, nxt, pf, o);
    } else {
        LGKM_WAIT1(3, cur[0]); o[DT] = MFMA32(cur[0], pf[0], o[DT]);
        LGKM_WAIT1(2, cur[1]); o[DT] = MFMA32(cur[1], pf[1], o[DT]);
        LGKM_WAIT1(1, cur[2]); o[DT] = MFMA32(cur[2], pf[2], o[DT]);
        LGKM_WAIT1(0, cur[3]); o[DT] = MFMA32(cur[3], pf[3], o[DT]);
    }
}
template <int NDT>
DI void pv_tile(const char* Vs, bf16x8 (&vf0)[4], const bf16x8 (&pf)[4], int r, int h, f32x16 (&o)[NDT]) {
    const int sw = (r >> 1) & 7;
    const unsigned vb = lds_addr(Vs) + r * VT_PITCH;
    unsigned va[4];
#pragma unroll
    for (int st = 0; st < 4; ++st) va[st] = vb + (((2 * st + h) ^ sw) << 4);
    pv_steps<NDT, 0>(va, vf0, pf, o);
}
DI void pack_p(const f32x16& p0, const f32x16& p1, bf16x8 (&pf)[4]) {
#pragma unroll
    for (int s = 0; s < 2; ++s) {
        u32x4 a, b;
        a.x = pk2(p0[8 * s + 0], p0[8 * s + 1]); a.y = pk2(p0[8 * s + 2], p0[8 * s + 3]); a.z = pk2(p0[8 * s + 4], p0[8 * s + 5]); a.w = pk2(p0[8 * s + 6], p0[8 * s + 7]);
        b.x = pk2(p1[8 * s + 0], p1[8 * s + 1]); b.y = pk2(p1[8 * s + 2], p1[8 * s + 3]); b.z = pk2(p1[8 * s + 4], p1[8 * s + 5]); b.w = pk2(p1[8 * s + 6], p1[8 * s + 7]);
        pf[s] = __builtin_bit_cast(bf16x8, a);
        pf[2 + s] = __builtin_bit_cast(bf16x8, b);
    }
}
template <int MODE>
DI void mask_tile(f32x16& s0, f32x16& s1, int h, int tq, int stride, int dmax, bool lane_ok, const float* tab) {
    if (MODE == 1) {
        if (!lane_ok) {
#pragma unroll
            for (int i = 0; i < 16; ++i) { s0[i] = NEGB; s1[i] = NEGB; }
        }
    } else if (MODE == 2) {
        const unsigned udm = (unsigned)dmax;
#pragma unroll
        for (int g4 = 0; g4 < 4; ++g4) {
            float bb[8]; int dd[8];
#pragma unroll
            for (int e = 0; e < 4; ++e) {
                const int k0 = kidx(4 * g4 + e, h);
                dd[2 * e] = tq - stride * k0; dd[2 * e + 1] = tq - stride * (k0 + 32);
            }
#pragma unroll
            for (int e = 0; e < 8; ++e) { const int ix = dd[e] < 0 ? 0 : (dd[e] > 127 ? 127 : dd[e]); bb[e] = tab[ix]; }
            asm volatile("" : "+v"(bb[0]), "+v"(bb[1]), "+v"(bb[2]), "+v"(bb[3]), "+v"(bb[4]), "+v"(bb[5]), "+v"(bb[6]), "+v"(bb[7]));
#pragma unroll
            for (int e = 0; e < 4; ++e) {
                const int i = 4 * g4 + e;
                const bool v0 = lane_ok && (unsigned)dd[2 * e] < udm, v1 = lane_ok && (unsigned)dd[2 * e + 1] < udm;
                s0[i] = v0 ? s0[i] + bb[2 * e] : NEGB;
                s1[i] = v1 ? s1[i] + bb[2 * e + 1] : NEGB;
            }
        }
    }
}
DI float max2(float a, float b) { return __builtin_amdgcn_fmed3f(a, b, __builtin_inff()); }
DI float max3f(float a, float b, float c) { float r; asm("v_max3_f32 %0, %1, %2, %3" : "=v"(r) : "v"(a), "v"(b), "v"(c)); return r; }
DI float max2f(float a, float b) { float r; asm("v_max_f32_e32 %0, %1, %2" : "=v"(r) : "v"(a), "v"(b)); return r; }
DI float tile_max(const f32x16& s0, const f32x16& s1) {
    float a = max3f(s0[0], s0[1], s1[0]), b = max3f(s0[2], s0[3], s1[1]);
    a = max3f(a, s1[2], s1[3]);
#pragma unroll
    for (int i = 4; i < 16; i += 4) { a = max3f(a, s0[i], s0[i + 1]); b = max3f(b, s0[i + 2], s0[i + 3]); a = max3f(a, s1[i], s1[i + 1]); b = max3f(b, s1[i + 2], s1[i + 3]); }
    return max2f(a, b);
}
typedef float f32x2 __attribute__((ext_vector_type(2)));
constexpr float M_INIT = -64.f;
DI float exp_sum(f32x16& s0, f32x16& s1) {
    f32x2 acc0 = {0.f, 0.f}, acc1 = {0.f, 0.f};
#pragma unroll
    for (int i = 0; i < 16; i += 2) {
        const float a0 = __builtin_amdgcn_exp2f(s0[i]), a1 = __builtin_amdgcn_exp2f(s0[i + 1]), b0 = __builtin_amdgcn_exp2f(s1[i]), b1 = __builtin_amdgcn_exp2f(s1[i + 1]);
        s0[i] = a0; s0[i + 1] = a1; s1[i] = b0; s1[i + 1] = b1;
        acc0 += (f32x2){a0, a1}; acc1 += (f32x2){b0, b1};
    }
    acc0 += acc1;
    return acc0.x + acc0.y;
}
template <int MODE, int NDT>
DI void softmax_step(f32x16& s0, f32x16& s1, f32x16& negm, float& l, f32x16 (&o)[NDT], bool lane_ok) {
    float mx = tile_max(s0, s1);
    if (MODE == 1) mx = lane_ok ? mx : NEGB;
    if (__any(mx > RESCALE_THR)) {
        mx = max2(mx, __shfl_xor(mx, 32));
        const float d = max2(mx, 0.f);
        const float alpha = __builtin_amdgcn_exp2f(-d);
        const float nm = negm[0] - d;
        l *= alpha;
#pragma unroll
        for (int dt = 0; dt < NDT; ++dt)
#pragma unroll
            for (int i = 0; i < 16; ++i) o[dt][i] *= alpha;
#pragma unroll
        for (int i = 0; i < 16; ++i) { s0[i] -= d; s1[i] -= d; negm[i] = nm; }
    }
    f32x2 acc0 = {0.f, 0.f}, acc1 = {0.f, 0.f};
#pragma unroll
    for (int i = 0; i < 16; i += 2) {
        const float a0 = __builtin_amdgcn_exp2f(s0[i]), a1 = __builtin_amdgcn_exp2f(s0[i + 1]), b0 = __builtin_amdgcn_exp2f(s1[i]), b1 = __builtin_amdgcn_exp2f(s1[i + 1]);
        s0[i] = a0; s0[i + 1] = a1; s1[i] = b0; s1[i + 1] = b1;
        acc0 += (f32x2){a0, a1}; acc1 += (f32x2){b0, b1};
    }
    acc0 += acc1;
    const float sum = acc0.x + acc0.y;
    l += (MODE == 1) ? (lane_ok ? sum : 0.f) : sum;
}
template <bool EDGE>
DI void build_vtab(float* T, const float* tab2g, int N, int D0, int i0, int step) {
    for (int idx = i0; idx < 4 * N; idx += step) {
        const int p = idx / N, k = idx - p * N, d = D0 - (k + p);
        float v;
        if (EDGE) v = d < 512 ? 0.f : NEGB;
        else v = d < 0 ? NEGB : (d < 128 ? tab2g[d] : 0.f);
        T[idx] = v;
    }
}
DI void mask_vec(f32x16& s0, f32x16& s1, int h, int tq, const float* T, int N, int D0) {
    const int x0 = D0 - tq + 8 * h, p = x0 & 3;
    const float* base = T + p * N + (x0 - p);
    f32x4 v[8];
#pragma unroll
    for (int kh = 0; kh < 2; ++kh)
#pragma unroll
        for (int g = 0; g < 4; ++g) v[4 * kh + g] = *(const f32x4*)(base + 4 * (g & 1) + 16 * (g >> 1) + 32 * kh);
#pragma unroll
    for (int g = 0; g < 4; ++g) {
        s0[4 * g] += v[g].x; s0[4 * g + 1] += v[g].y; s0[4 * g + 2] += v[g].z; s0[4 * g + 3] += v[g].w;
        s1[4 * g] += v[4 + g].x; s1[4 * g + 1] += v[4 + g].y; s1[4 * g + 2] += v[4 + g].z; s1[4 * g + 3] += v[4 + g].w;
    }
}
template <int MODE, int NDT>
DI void attn_tile(const char* Ks, const char* Vs, const bf16x8 (&qf)[4], int r_in, int h_in, f32x16& negm, float& l, f32x16 (&o)[NDT],
                  int tq, int stride, int dmax, bool lane_ok, const float* tab) {
    int lane_ = r_in + 32 * h_in;
    asm volatile("" : "+v"(lane_), "+v"(tq));
    const int r = lane_ & 31, h = lane_ >> 5;
    f32x16 s0, s1;
    qk_tile(Ks, qf, r, h, negm, s0, s1);
    bf16x8 vf0[4];
    v_prefetch(Vs, r, h, vf0);
    if (MODE == 2) mask_tile<2>(s0, s1, h, tq, stride, dmax, lane_ok, tab);
    if (MODE == 3) mask_vec(s0, s1, h, tq, tab, stride, dmax);
    softmax_step<(MODE == 1 || MODE == 3) ? 1 : 0, NDT>(s0, s1, negm, l, o, lane_ok);
    bf16x8 pf[4];
    pack_p(s0, s1, pf);
    if (MODE == 1 || MODE == 3) {
#pragma unroll
        for (int i = 0; i < 4; ++i) {
            u32x4 v = __builtin_bit_cast(u32x4, pf[i]);
            v.x = lane_ok ? v.x : 0u; v.y = lane_ok ? v.y : 0u; v.z = lane_ok ? v.z : 0u; v.w = lane_ok ? v.w : 0u;
            pf[i] = __builtin_bit_cast(bf16x8, v);
        }
    }
    pv_tile<NDT>(Vs, vf0, pf, r, h, o);
}

template <int OFF> DI bf16x8 ds128m(unsigned a) { bf16x8 v; asm volatile("ds_read_b128 %0, %1 offset:%2" : "=v"(v) : "v"(a), "n"(OFF) : "memory"); return v; }
#define LGKM_WAITM(n, a) asm volatile("s_waitcnt lgkmcnt(" #n ")" : "+v"(a) :: "memory")
constexpr float SUM_BIG = 0x1p40f;
template <bool COL>
DI float half_exp(const f32x16& sv, bf16x8& pa, bf16x8& pb, bool lane_ok) {
    f32x2 acc = {0.f, 0.f};
    u32x4 a, b;
    {
        const float e0 = __builtin_amdgcn_exp2f(sv[0]), e1 = __builtin_amdgcn_exp2f(sv[1]), e2 = __builtin_amdgcn_exp2f(sv[2]), e3 = __builtin_amdgcn_exp2f(sv[3]);
        const float e4 = __builtin_amdgcn_exp2f(sv[4]), e5 = __builtin_amdgcn_exp2f(sv[5]), e6 = __builtin_amdgcn_exp2f(sv[6]), e7 = __builtin_amdgcn_exp2f(sv[7]);
        acc += (f32x2){e0, e1}; acc += (f32x2){e2, e3}; acc += (f32x2){e4, e5}; acc += (f32x2){e6, e7};
        a.x = pk2(e0, e1); a.y = pk2(e2, e3); a.z = pk2(e4, e5); a.w = pk2(e6, e7);
    }
    {
        const float e0 = __builtin_amdgcn_exp2f(sv[8]), e1 = __builtin_amdgcn_exp2f(sv[9]), e2 = __builtin_amdgcn_exp2f(sv[10]), e3 = __builtin_amdgcn_exp2f(sv[11]);
        const float e4 = __builtin_amdgcn_exp2f(sv[12]), e5 = __builtin_amdgcn_exp2f(sv[13]), e6 = __builtin_amdgcn_exp2f(sv[14]), e7 = __builtin_amdgcn_exp2f(sv[15]);
        acc += (f32x2){e0, e1}; acc += (f32x2){e2, e3}; acc += (f32x2){e4, e5}; acc += (f32x2){e6, e7};
        b.x = pk2(e0, e1); b.y = pk2(e2, e3); b.z = pk2(e4, e5); b.w = pk2(e6, e7);
    }
    if (COL) {
        a.x = lane_ok ? a.x : 0u; a.y = lane_ok ? a.y : 0u; a.z = lane_ok ? a.z : 0u; a.w = lane_ok ? a.w : 0u;
        b.x = lane_ok ? b.x : 0u; b.y = lane_ok ? b.y : 0u; b.z = lane_ok ? b.z : 0u; b.w = lane_ok ? b.w : 0u;
    }
    pa = __builtin_bit_cast(bf16x8, a); pb = __builtin_bit_cast(bf16x8, b);
    const float sum = acc.x + acc.y;
    return COL ? (lane_ok ? sum : 0.f) : sum;
}
template <bool COL, int NDT>
DI float half_rescale(f32x16& sv, float d_pend, f32x16& negm, float& l, f32x16 (&o)[NDT], bool lane_ok) {
    float mx = NEGB;
#pragma unroll
    for (int i = 0; i < 16; ++i) { sv[i] -= d_pend; mx = max2(mx, sv[i]); }
    if (COL) mx = lane_ok ? mx : NEGB;
    mx = max2(mx, __shfl_xor(mx, 32));
    const float d = max2(mx, 0.f);
    const float alpha = __builtin_amdgcn_exp2f(-d);
    const float nm = negm[0] - d;
    l *= alpha;
#pragma unroll
    for (int dt = 0; dt < NDT; ++dt)
#pragma unroll
        for (int i = 0; i < 16; ++i) o[dt][i] *= alpha;
#pragma unroll
    for (int i = 0; i < 16; ++i) { sv[i] -= d; negm[i] = nm; }
    return d;
}
template <int NDT, int I>
DI void pv2_steps(const unsigned (&va)[4], bf16x8 (&win)[4], const bf16x8 (&pf)[4], f32x16 (&o)[NDT]) {
    constexpr int TOT = 4 * NDT;
    if constexpr (I < TOT) {
        constexpr int part = I / (2 * NDT), dt = (I % (2 * NDT)) / 2, st = 2 * part + (I & 1);
        constexpr int left = TOT - 1 - I;
        if constexpr (left >= 3) LGKM_WAITM(3, win[I & 3]); else if constexpr (left == 2) LGKM_WAITM(2, win[I & 3]); else if constexpr (left == 1) LGKM_WAITM(1, win[I & 3]); else LGKM_WAITM(0, win[I & 3]);
        o[dt] = MFMA32(win[I & 3], pf[st], o[dt]);
        if constexpr (I + 4 < TOT) {
            constexpr int J = I + 4, part2 = J / (2 * NDT), dt2 = (J % (2 * NDT)) / 2, st2 = 2 * part2 + (J & 1);
            win[I & 3] = ds128m<32 * VT_PITCH * dt2>(va[st2]);
        }
    }
}
template <bool BIAS>
DI void exp_unit(f32x16& sv, int u, const f32x4* bv, f32x2& acc, unsigned (&w)[8]) {
    if (BIAS) { const f32x4 q = bv[u >> 1]; sv[2 * u] += (u & 1) ? q.z : q.x; sv[2 * u + 1] += (u & 1) ? q.w : q.y; }
    const float e0 = __builtin_amdgcn_exp2f(sv[2 * u]), e1 = __builtin_amdgcn_exp2f(sv[2 * u + 1]);
    acc += (f32x2){e0, e1};
    w[u] = pk2(e0, e1);
}
template <bool COL>
DI float half_finish(const f32x2& acc, unsigned (&w)[8], bf16x8& pa, bf16x8& pb, bool lane_ok) {
    if (COL) {
#pragma unroll
        for (int i = 0; i < 8; ++i) w[i] = lane_ok ? w[i] : 0u;
    }
    pa = __builtin_bit_cast(bf16x8, ((u32x4){w[0], w[1], w[2], w[3]})); pb = __builtin_bit_cast(bf16x8, ((u32x4){w[4], w[5], w[6], w[7]}));
    const float sum = acc.x + acc.y;
    return COL ? (lane_ok ? sum : 0.f) : sum;
}
template <int MODE, int NDT>
DI void attn_tile2(const char* Ks, const char* Vs, const bf16x8 (&qf)[4], int r_in, int h_in, f32x16& negm, float& l, f32x16 (&o)[NDT],
                   int tq, int tabN, int tabD0, bool lane_ok, const float* tab) {
    int lane_ = r_in + 32 * h_in;
    asm volatile("" : "+v"(lane_), "+v"(tq));
    const int r = lane_ & 31, h = lane_ >> 5, sw = (r >> 1) & 7;
    constexpr bool COL = (MODE == 1 || MODE == 3), BIAS = (MODE == 3);
    f32x4 bv[8];
    if (BIAS) {
        const int x0 = tabD0 - tq + 8 * h, p = x0 & 3;
        const float* base = tab + p * tabN + (x0 - p);
#pragma unroll
        for (int kh = 0; kh < 2; ++kh)
#pragma unroll
            for (int g = 0; g < 4; ++g) bv[4 * kh + g] = *(const f32x4*)(base + 4 * (g & 1) + 16 * (g >> 1) + 32 * kh);
    }
    const unsigned kb = lds_addr(Ks) + r * 128, vb = lds_addr(Vs) + r * VT_PITCH;
    unsigned ka[4], va[4];
#pragma unroll
    for (int ks = 0; ks < 4; ++ks) { const unsigned fo = (unsigned)(((2 * ks + h) ^ sw) << 4); ka[ks] = kb + fo; va[ks] = vb + fo; }
    bf16x8 k0[4], k1[4], win[4];
#pragma unroll
    for (int ks = 0; ks < 4; ++ks) k0[ks] = ds128m<0>(ka[ks]);
#pragma unroll
    for (int ks = 0; ks < 4; ++ks) k1[ks] = ds128m<4096>(ka[ks]);
    f32x16 s0, s1;
    LGKM_WAITM(7, k0[0]); s0 = MFMA32(k0[0], qf[0], negm);
    LGKM_WAITM(6, k0[1]); s0 = MFMA32(k0[1], qf[1], s0);
    LGKM_WAITM(5, k0[2]); s0 = MFMA32(k0[2], qf[2], s0);
    LGKM_WAITM(4, k0[3]); s0 = MFMA32(k0[3], qf[3], s0);
    win[0] = ds128m<0>(va[0]); win[1] = ds128m<0>(va[1]);
    win[2] = ds128m<32 * VT_PITCH>(va[0]); win[3] = ds128m<32 * VT_PITCH>(va[1]);
    MFMA_FENCE;
    f32x2 acc0 = {0.f, 0.f};
    unsigned w0[8];
    LGKM_WAITM(7, k1[0]); s1 = MFMA32(k1[0], qf[0], negm); exp_unit<BIAS>(s0, 0, bv, acc0, w0); exp_unit<BIAS>(s0, 1, bv, acc0, w0); MFMA_FENCE;
    LGKM_WAITM(6, k1[1]); s1 = MFMA32(k1[1], qf[1], s1);   exp_unit<BIAS>(s0, 2, bv, acc0, w0); exp_unit<BIAS>(s0, 3, bv, acc0, w0); MFMA_FENCE;
    LGKM_WAITM(5, k1[2]); s1 = MFMA32(k1[2], qf[2], s1);   exp_unit<BIAS>(s0, 4, bv, acc0, w0); exp_unit<BIAS>(s0, 5, bv, acc0, w0); MFMA_FENCE;
    LGKM_WAITM(4, k1[3]); s1 = MFMA32(k1[3], qf[3], s1);   exp_unit<BIAS>(s0, 6, bv, acc0, w0); exp_unit<BIAS>(s0, 7, bv, acc0, w0); MFMA_FENCE;
    bf16x8 pf[4];
    float sum0 = half_finish<COL>(acc0, w0, pf[0], pf[1], lane_ok);
    float d0 = 0.f;
    const bool resc0 = __any(!(sum0 <= SUM_BIG));
    if (resc0) {
        d0 = half_rescale<COL, NDT>(s0, 0.f, negm, l, o, lane_ok);
        sum0 = half_exp<COL>(s0, pf[0], pf[1], lane_ok);
    }
    l += sum0;
    f32x2 acc1 = {0.f, 0.f};
    unsigned w1[8];
    if constexpr (NDT == 4) {
        pv2_steps<NDT, 0>(va, win, pf, o); exp_unit<BIAS>(s1, 0, bv + 4, acc1, w1); MFMA_FENCE;
        pv2_steps<NDT, 1>(va, win, pf, o); exp_unit<BIAS>(s1, 1, bv + 4, acc1, w1); MFMA_FENCE;
        pv2_steps<NDT, 2>(va, win, pf, o); exp_unit<BIAS>(s1, 2, bv + 4, acc1, w1); MFMA_FENCE;
        pv2_steps<NDT, 3>(va, win, pf, o); exp_unit<BIAS>(s1, 3, bv + 4, acc1, w1); MFMA_FENCE;
        pv2_steps<NDT, 4>(va, win, pf, o); exp_unit<BIAS>(s1, 4, bv + 4, acc1, w1); MFMA_FENCE;
        pv2_steps<NDT, 5>(va, win, pf, o); exp_unit<BIAS>(s1, 5, bv + 4, acc1, w1); MFMA_FENCE;
        pv2_steps<NDT, 6>(va, win, pf, o); exp_unit<BIAS>(s1, 6, bv + 4, acc1, w1); MFMA_FENCE;
        pv2_steps<NDT, 7>(va, win, pf, o); exp_unit<BIAS>(s1, 7, bv + 4, acc1, w1); MFMA_FENCE;
    } else {
        pv2_steps<NDT, 0>(va, win, pf, o); exp_unit<BIAS>(s1, 0, bv + 4, acc1, w1); exp_unit<BIAS>(s1, 1, bv + 4, acc1, w1); MFMA_FENCE;
        pv2_steps<NDT, 1>(va, win, pf, o); exp_unit<BIAS>(s1, 2, bv + 4, acc1, w1); exp_unit<BIAS>(s1, 3, bv + 4, acc1, w1); MFMA_FENCE;
        pv2_steps<NDT, 2>(va, win, pf, o); exp_unit<BIAS>(s1, 4, bv + 4, acc1, w1); exp_unit<BIAS>(s1, 5, bv + 4, acc1, w1); MFMA_FENCE;
        pv2_steps<NDT, 3>(va, win, pf, o); exp_unit<BIAS>(s1, 6, bv + 4, acc1, w1); exp_unit<BIAS>(s1, 7, bv + 4, acc1, w1); MFMA_FENCE;
    }
    bf16x8 pf2a, pf2b;
    float sum1 = half_finish<COL>(acc1, w1, pf2a, pf2b, lane_ok);
    const bool trig1 = __any(!(sum1 <= SUM_BIG));
    if (resc0 | trig1) {
        (void)half_rescale<COL, NDT>(s1, d0, negm, l, o, lane_ok);
        sum1 = half_exp<COL>(s1, pf2a, pf2b, lane_ok);
    }
    l += sum1;
    pf[2] = pf2a; pf[3] = pf2b;
    if constexpr (NDT == 4) {
        pv2_steps<NDT, 8>(va, win, pf, o); pv2_steps<NDT, 9>(va, win, pf, o); pv2_steps<NDT, 10>(va, win, pf, o); pv2_steps<NDT, 11>(va, win, pf, o);
        pv2_steps<NDT, 12>(va, win, pf, o); pv2_steps<NDT, 13>(va, win, pf, o); pv2_steps<NDT, 14>(va, win, pf, o); pv2_steps<NDT, 15>(va, win, pf, o);
    } else {
        pv2_steps<NDT, 4>(va, win, pf, o); pv2_steps<NDT, 5>(va, win, pf, o); pv2_steps<NDT, 6>(va, win, pf, o); pv2_steps<NDT, 7>(va, win, pf, o);
    }
}

DI void nsa_dma(const bf16_t* kbase, int kpitch, const bf16_t* vbase, int vpitch, int krow0, int vcol0, char* Kbuf, char* Vbuf, bool with_v, int lane, int widu) {
    const int rho = 8 * widu + (lane >> 3), c = (lane & 7) ^ ((rho >> 1) & 7);
    glds16(kbase + (size_t)(krow0 + kperm(rho)) * kpitch + c * 8, Kbuf + widu * 1024);
    if (with_v) glds16(vbase + (size_t)rho * vpitch + vcol0 + c * 8, Vbuf + widu * 1024);
}

DI unsigned ord_key(float f) { const unsigned u = __float_as_uint(f); return (u & 0x80000000u) ? ~u : (u | 0x80000000u); }
DI float unord_key(unsigned k) { return __uint_as_float((k & 0x80000000u) ? (k & 0x7fffffffu) : ~k); }
#define CE_DESC(a, b) do { const unsigned hi_ = (a) > (b) ? (a) : (b); const unsigned lo_ = (a) > (b) ? (b) : (a); (a) = hi_; (b) = lo_; } while (0)
DI void sort16_desc(unsigned (&k)[16]) {
#pragma unroll
    for (int size = 2; size <= 16; size <<= 1)
#pragma unroll
        for (int stride = size >> 1; stride > 0; stride >>= 1)
#pragma unroll
            for (int i = 0; i < 16; ++i) {
                const int j = i ^ stride;
                if (j > i) { if ((i & size) == 0) CE_DESC(k[i], k[j]); else CE_DESC(k[j], k[i]); }
            }
}
DI void merge16_desc(unsigned (&v)[16], const unsigned (&k)[16]) {
#pragma unroll
    for (int i = 0; i < 16; ++i) v[i] = v[i] > k[15 - i] ? v[i] : k[15 - i];
#pragma unroll
    for (int stride = 8; stride > 0; stride >>= 1)
#pragma unroll
        for (int i = 0; i < 16; ++i) { const int j = i ^ stride; if (j > i) CE_DESC(v[i], v[j]); }
}
DI void sort8_desc(unsigned (&k)[8]) {
#pragma unroll
    for (int size = 2; size <= 8; size <<= 1)
#pragma unroll
        for (int stride = size >> 1; stride > 0; stride >>= 1)
#pragma unroll
            for (int i = 0; i < 8; ++i) {
                const int j = i ^ stride;
                if (j > i) { if ((i & size) == 0) CE_DESC(k[i], k[j]); else CE_DESC(k[j], k[i]); }
            }
}
template <int CTRL> DI unsigned dpp_mov(unsigned x) { return (unsigned)__builtin_amdgcn_mov_dpp((int)x, CTRL, 0xf, 0xf, true); }

constexpr int NSA_K = 0, NSA_V = 16384, NSA_IMPM = NSA_V + 2 * 64 * VT_PITCH, NSA_IMPC = NSA_IMPM + 64 * 65 * 4, NSA_MASK = NSA_IMPC + 64 * 65 * 4,
              NSA_TAB = NSA_MASK + 512, NSA_OACC = NSA_TAB + 4 * 128 * 4, NSA_VTAB = NSA_OACC + 256 * 68 * 4, NSA_ETAB = NSA_VTAB + 4 * 4 * 272 * 4, NSA_END = NSA_ETAB + 4 * 144 * 4;
constexpr int NSA_VN = 272, NSA_VD0 = 191, NSA_EN = 144, NSA_ED0 = 575;
static_assert(NSA_END <= LDS_BYTES && (NSA_IMPM % 16) == 0 && (NSA_OACC % 16) == 0, "NSA LDS map");
#define NSA_KB(i) (smem + NSA_K + ((i) & 1) * 8192)
#define NSA_VB(i) (smem + NSA_V + ((i) & 1) * (64 * VT_PITCH))

DI void nsa_unit(const Params& P, char* smem, int b, int g, int cur) {
    const int tid = ltid(), lane = tid & 63, wid = tid >> 6, r = lane & 31, h = lane >> 5, hh = r >> 3, ti = r & 7;
    const int tl = 8 * wid + ti, t = 64 * cur + tl;
    const size_t tg = (size_t)b * SEQ + t;
    const int bg = b * 2 + g, head = g * 4 + hh;
    float* impM = (float*)(smem + NSA_IMPM); float* impC = (float*)(smem + NSA_IMPC);
    unsigned long long* mask64 = (unsigned long long*)(smem + NSA_MASK);
    float* tabL = (float*)(smem + NSA_TAB);
    const float* tabG = (const float*)(P.ws + OFF_TAB);
    __syncthreads();
    for (int i = tid; i < 4 * 128; i += NTHREADS) tabL[i] = tabG[(g * 4) * 128 + i];
    {
        const int q = tid >> 7;
        build_vtab<false>((float*)(smem + NSA_VTAB) + q * 4 * NSA_VN, tabG + (g * 4 + q) * 128, NSA_VN, NSA_VD0, tid & 127, 128);
        build_vtab<true>((float*)(smem + NSA_ETAB), tabG, NSA_EN, NSA_ED0, tid, NTHREADS);
    }
    const float* vtab = (const float*)(smem + NSA_VTAB) + hh * 4 * NSA_VN;
    const float* etab = (const float*)(smem + NSA_ETAB);
    for (int i = tid; i < 2 * 64 * 65; i += NTHREADS) impM[i] = 0.f;
    const float* tab = tabL + hh * 128;
    bf16x8 qf[4];
    {
        const bf16_t* qrow = (const bf16_t*)(P.ws + OFF_QN) + tg * 512 + g * 256 + hh * 64 + 8 * h;
#pragma unroll
        for (int ks = 0; ks < 4; ++ks) qf[ks] = *(const bf16x8*)(qrow + 16 * ks);
    }
    const float* gp = (const float*)(P.ws + OFF_GATES) + tg * 24 + head * 3;
    const float gate_c = gp[0], gate_s = gp[1], gate_w = gp[2];
    float* oaccL = (float*)(smem + NSA_OACC) + (tl * 4 + hh) * 68 + 4 * h;
    const int widu = __builtin_amdgcn_readfirstlane(wid);

    const bf16_t* kcmp = (const bf16_t*)(P.ws + OFF_KCMP) + (size_t)bg * 256 * 64;
    const bf16_t* vcmpT = (const bf16_t*)(P.ws + OFF_VCMPT) + (size_t)bg * 64 * 256;
    const int nvis = 4 * cur + 3;
    const int nct = (nvis + 63) >> 6;
    float mc = NEGB, lc = 0.f;
    nsa_dma(kcmp, 64, vcmpT, 256, 0, 0, NSA_KB(0), NSA_VB(0), false, lane, widu);
    __syncthreads();
    for (int ct = 0; ct < nct; ++ct) {
        if (ct + 1 < nct) nsa_dma(kcmp, 64, vcmpT, 256, 64 * (ct + 1), 64 * (ct + 1), NSA_KB(ct + 1), NSA_VB(ct + 1), false, lane, widu);
        f32x16 s0, s1, zero;
#pragma unroll
        for (int i = 0; i < 16; ++i) zero[i] = 0.f;
        int lane_ = lane, tq_ = t - 31 - 16 * 64 * ct;
        asm volatile("" : "+v"(lane_), "+v"(tq_));
        qk_tile(NSA_KB(ct), qf, lane_ & 31, lane_ >> 5, zero, s0, s1);
        if (64 * cur < 1167 + 1024 * ct) mask_tile<2>(s0, s1, lane_ >> 5, tq_, 16, 0x7fffffff, true, tab);
        float mx = tile_max(s0, s1);
        mx = max2(mx, __shfl_xor(mx, 32));
        const float mn = max2(mc, mx);
        const float alpha = __builtin_amdgcn_exp2f(mc - mn);
        mc = mn;
        const float mref = max2(mn, -1e20f);
#pragma unroll
        for (int i = 0; i < 16; ++i) { s0[i] -= mref; s1[i] -= mref; }
        lc = lc * alpha + exp_sum(s0, s1);
        __syncthreads();
    }
    {
        const float lt = lc + __shfl_xor(lc, 32);
        const float inv = lt > 0.f ? 1.0f / lt : 0.f;
        f32x16 oc[2];
#pragma unroll
        for (int i = 0; i < 16; ++i) { oc[0][i] = 0.f; oc[1][i] = 0.f; }
        nsa_dma(kcmp, 64, vcmpT, 256, 0, 0, NSA_KB(0), NSA_VB(0), true, lane, widu);
        f32x16 negmc;
#pragma unroll
        for (int i = 0; i < 16; ++i) negmc[i] = -mc;
        __syncthreads();
        for (int ct = 0; ct < nct; ++ct) {
            if (ct + 1 < nct) nsa_dma(kcmp, 64, vcmpT, 256, 64 * (ct + 1), 64 * (ct + 1), NSA_KB(ct + 1), NSA_VB(ct + 1), true, lane, widu);
            f32x16 s0, s1;
            int lane_ = lane, tq_ = t - 31 - 16 * 64 * ct;
            asm volatile("" : "+v"(lane_), "+v"(tq_));
            qk_tile(NSA_KB(ct), qf, lane_ & 31, lane_ >> 5, negmc, s0, s1);
            bf16x8 vf0[4];
            v_prefetch(NSA_VB(ct), lane_ & 31, lane_ >> 5, vf0);
            if (64 * cur < 1167 + 1024 * ct) mask_tile<2>(s0, s1, lane_ >> 5, tq_, 16, 0x7fffffff, true, tab);
#pragma unroll
            for (int i = 0; i < 16; ++i) {
                s0[i] = __builtin_amdgcn_exp2f(s0[i]) * inv;
                s1[i] = __builtin_amdgcn_exp2f(s1[i]) * inv;
            }
#pragma unroll
            for (int kh = 0; kh < 2; ++kh)
#pragma unroll
                for (int gi = 0; gi < 4; ++gi) {
                    const float p0 = kh ? s1[4 * gi] : s0[4 * gi], p1 = kh ? s1[4 * gi + 1] : s0[4 * gi + 1], p2 = kh ? s1[4 * gi + 2] : s0[4 * gi + 2], p3 = kh ? s1[4 * gi + 3] : s0[4 * gi + 3];
                    float hv = (p0 + p1) + (p2 + 0.5f * p3), cv = 0.5f * p3;
                    hv += __shfl_xor(hv, 8); hv += __shfl_xor(hv, 16);
                    cv += __shfl_xor(cv, 8); cv += __shfl_xor(cv, 16);
                    if (hh == 0) {
                        const int j = 16 * ct + 8 * kh + (gi & 1) + 2 * (lane_ >> 5) + 4 * (gi >> 1);
                        impM[tl * 65 + j] = hv;
                        impC[tl * 65 + j + 1] = cv;
                    }
                }
            bf16x8 pf[4];
            pack_p(s0, s1, pf);
            pv_tile<2>(NSA_VB(ct), vf0, pf, lane_ & 31, lane_ >> 5, oc);
            __syncthreads();
        }
#pragma unroll
        for (int dt = 0; dt < 2; ++dt)
#pragma unroll
            for (int gi = 0; gi < 4; ++gi)
                *(f32x4*)(oaccL + 32 * dt + 8 * gi) = (f32x4){gate_c * oc[dt][4 * gi], gate_c * oc[dt][4 * gi + 1], gate_c * oc[dt][4 * gi + 2], gate_c * oc[dt][4 * gi + 3]};
    }
    {
        const int tk = 8 * wid + (lane >> 3), jb = (lane & 7) * 8;
        unsigned key[8], sk[8];
#pragma unroll
        for (int e = 0; e < 8; ++e) {
            const int j = jb + e;
            const float imp = impM[tk * 65 + j] + impC[tk * 65 + j];
            const float my = (j == 0 || j == cur || j == cur - 1) ? 1e9f : (j <= cur ? imp : NEGB);
            key[e] = (ord_key(my) & ~63u) | (unsigned)(63 - j);
            sk[e] = key[e];
        }
        sort8_desc(sk);
        unsigned v[16], k2[16];
#pragma unroll
        for (int i = 0; i < 8; ++i) { v[i] = sk[i]; v[15 - i] = dpp_mov<0xB1>(sk[i]); }
#pragma unroll
        for (int stride = 8; stride > 0; stride >>= 1)
#pragma unroll
            for (int i = 0; i < 16; ++i) { const int j = i ^ stride; if (j > i) CE_DESC(v[i], v[j]); }
#pragma unroll
        for (int i = 0; i < 16; ++i) k2[i] = dpp_mov<0x4E>(v[i]);
        merge16_desc(v, k2);
#pragma unroll
        for (int i = 0; i < 16; ++i) k2[i] = dpp_mov<0x141>(v[i]);
        merge16_desc(v, k2);
        const unsigned thr = v[15];
        unsigned bits = 0;
#pragma unroll
        for (int e = 0; e < 8; ++e) bits |= (key[e] >= thr && (jb + e) <= cur) ? (1u << e) : 0u;
        ((unsigned char*)mask64)[tk * 8 + (lane & 7)] = (unsigned char)bits;
    }
    __syncthreads();
    const unsigned long long mymask = mask64[tl];
    unsigned long long uni;
    {
        const unsigned long long mm = mask64[lane];
        unsigned lo = (unsigned)mm, hi2 = (unsigned)(mm >> 32);
#pragma unroll
        for (int o = 1; o < 64; o <<= 1) { lo |= __shfl_xor(lo, o); hi2 |= __shfl_xor(hi2, o); }
        uni = ((unsigned long long)hi2 << 32) | lo;
    }
    {
        const bf16_t* kb = (const bf16_t*)(P.ws + OFF_KS) + (size_t)b * SEQ * 128 + g * 64;
        const bf16_t* vb = (const bf16_t*)(P.ws + OFF_VST) + (size_t)bg * 64 * SEQ;
        float l = 0.f;
        f32x16 negm;
#pragma unroll
        for (int i = 0; i < 16; ++i) negm[i] = -M_INIT;
        f32x16 o[2];
#pragma unroll
        for (int i = 0; i < 16; ++i) { o[0][i] = 0.f; o[1][i] = 0.f; }
        int jc = 0;
        while (jc <= cur && !((uni >> jc) & 1ull)) ++jc;
        int jn = jc + 1;
        while (jn <= cur && !((uni >> jn) & 1ull)) ++jn;
        if (jc <= cur) nsa_dma(kb, 128, vb, SEQ, 64 * jc, 64 * jc, NSA_KB(0), NSA_VB(0), true, lane, widu);
        __syncthreads();
        for (int it = 0; jc <= cur; ++it) {
            if (jn <= cur) nsa_dma(kb, 128, vb, SEQ, 64 * jn, 64 * jn, NSA_KB(it + 1), NSA_VB(it + 1), true, lane, widu);
            const bool ok = (mymask >> jc) & 1ull;
            if (jc >= cur - 2) attn_tile<3, 2>(NSA_KB(it), NSA_VB(it), qf, r, h, negm, l, o, t - 64 * jc, NSA_VN, NSA_VD0, ok, vtab);
            else attn_tile<1, 2>(NSA_KB(it), NSA_VB(it), qf, r, h, negm, l, o, 0, 1, 0, ok, tab);
            __syncthreads();
            int jnn = jn + 1;
            while (jnn <= cur && !((uni >> jnn) & 1ull)) ++jnn;
            jc = jn; jn = jnn;
        }
        const float lt = l + __shfl_xor(l, 32);
        const float sc = lt > 0.f ? gate_s / lt : 0.f;
#pragma unroll
        for (int dt = 0; dt < 2; ++dt)
#pragma unroll
            for (int gi = 0; gi < 4; ++gi) {
                f32x4 a = *(const f32x4*)(oaccL + 32 * dt + 8 * gi);
                a.x += sc * o[dt][4 * gi]; a.y += sc * o[dt][4 * gi + 1]; a.z += sc * o[dt][4 * gi + 2]; a.w += sc * o[dt][4 * gi + 3];
                *(f32x4*)(oaccL + 32 * dt + 8 * gi) = a;
            }
    }
    {
        const bf16_t* kb = (const bf16_t*)(P.ws + OFF_KW) + (size_t)b * SEQ * 128 + g * 64;
        const bf16_t* vb = (const bf16_t*)(P.ws + OFF_VWT) + (size_t)bg * 64 * SEQ;
        float l = 0.f;
        f32x16 negm;
#pragma unroll
        for (int i = 0; i < 16; ++i) negm[i] = -M_INIT;
        f32x16 o[2];
#pragma unroll
        for (int i = 0; i < 16; ++i) { o[0][i] = 0.f; o[1][i] = 0.f; }
        const int j0 = cur >= 8 ? cur - 8 : 0;
        nsa_dma(kb, 128, vb, SEQ, 64 * j0, 64 * j0, NSA_KB(0), NSA_VB(0), true, lane, widu);
        __syncthreads();
        for (int j = j0; j <= cur; ++j) {
            const int it = j - j0;
            if (j + 1 <= cur) nsa_dma(kb, 128, vb, SEQ, 64 * (j + 1), 64 * (j + 1), NSA_KB(it + 1), NSA_VB(it + 1), true, lane, widu);
            if (j >= cur - 2) attn_tile<3, 2>(NSA_KB(it), NSA_VB(it), qf, r, h, negm, l, o, t - 64 * j, NSA_VN, NSA_VD0, true, vtab);
            else if (j == cur - 8) attn_tile<3, 2>(NSA_KB(it), NSA_VB(it), qf, r, h, negm, l, o, t - 64 * j, NSA_EN, NSA_ED0, true, etab);
            else attn_tile<0, 2>(NSA_KB(it), NSA_VB(it), qf, r, h, negm, l, o, 0, 1, 0, true, tab);
            __syncthreads();
        }
        const float lt = l + __shfl_xor(l, 32);
        const float sc = lt > 0.f ? gate_w / lt : 0.f;
        bf16_t* mp = (bf16_t*)(P.ws + OFF_H) + tg * DM + g * 256 + hh * 64;
#pragma unroll
        for (int dt = 0; dt < 2; ++dt)
#pragma unroll
            for (int gi = 0; gi < 4; ++gi) {
                f32x4 a = *(const f32x4*)(oaccL + 32 * dt + 8 * gi);
                a.x += sc * o[dt][4 * gi]; a.y += sc * o[dt][4 * gi + 1]; a.z += sc * o[dt][4 * gi + 2]; a.w += sc * o[dt][4 * gi + 3];
                st_bf4(mp + 32 * dt + 8 * gi + 4 * h, a, 1.f);
            }
    }
}

constexpr int DF_K = 0, DF_V = 32768, DF_TAB = DF_V + 2 * 128 * VT_PITCH, DF_O2 = DF_TAB + 4 * 336 * 4, DF_END = DF_O2 + 128 * 129 * 4;
constexpr int DF_VN = 336, DF_VD0 = 223;
static_assert(DF_END <= LDS_BYTES && (DF_TAB % 16) == 0, "diff LDS map");

DI void diff_unit(const Params& P, char* smem, int b, int hd, int qi, float lam) {
    const int tid = ltid(), lane = tid & 63, wid = tid >> 6, r = lane & 31, h = lane >> 5, qs = wid & 3, mp = wid >> 2;
    const int t0 = 128 * qi, t = t0 + 32 * qs + r;
    const size_t tg = (size_t)b * SEQ + t;
    float* tabL = (float*)(smem + DF_TAB);
    float* o2b = (float*)(smem + DF_O2);
    __syncthreads();
    build_vtab<false>(tabL, (const float*)(P.ws + OFF_TAB) + (8 + hd) * 128, DF_VN, DF_VD0, tid, NTHREADS);
    bf16x8 qf[4];
    {
        const bf16_t* qrow = (const bf16_t*)(P.ws + OFF_DQ) + tg * 512 + (hd * 2 + mp) * 64 + 8 * h;
#pragma unroll
        for (int ks = 0; ks < 4; ++ks) qf[ks] = *(const bf16x8*)(qrow + 16 * ks);
    }
    const bf16_t* kb = (const bf16_t*)(P.ws + OFF_DK) + (size_t)b * SEQ * 512 + hd * 128;
    const bf16_t* vb = (const bf16_t*)(P.ws + OFF_DVT) + (size_t)(b * 4 + hd) * 128 * SEQ;
    const int widu = __builtin_amdgcn_readfirstlane(wid);
#define DF_DMA(j, bi) do { _Pragma("unroll") for (int i_ = 0; i_ < 2; ++i_) { const int q_ = 2 * widu + i_; \
        const int rho_ = 8 * (q_ & 7) + (lane >> 3), ck_ = (lane & 7) ^ ((rho_ >> 1) & 7); \
        glds16(kb + (size_t)(64 * (j) + kperm(rho_)) * 512 + (q_ >> 3) * 64 + ck_ * 8, smem + DF_K + ((bi) & 1) * 16384 + q_ * 1024); \
        const int d_ = 8 * q_ + (lane >> 3), cv_ = (lane & 7) ^ ((d_ >> 1) & 7); \
        glds16(vb + (size_t)d_ * SEQ + 64 * (j) + cv_ * 8, smem + DF_V + ((bi) & 1) * (128 * VT_PITCH) + q_ * 1024); } } while (0)
    float l = 0.f;
    f32x16 negm;
#pragma unroll
    for (int i = 0; i < 16; ++i) negm[i] = -M_INIT;
    f32x16 o[4];
#pragma unroll
    for (int dt = 0; dt < 4; ++dt)
#pragma unroll
        for (int i = 0; i < 16; ++i) o[dt][i] = 0.f;
    const int ntile = 2 * qi + 2;
    const int tmin = t0 + 32 * qs;
    DF_DMA(0, 0);
    __syncthreads();
    for (int j = 0; j < ntile; ++j) {
        if (j + 1 < ntile) DF_DMA(j + 1, j + 1);
        const char* Ks = smem + DF_K + (j & 1) * 16384 + mp * 8192;
        const char* Vs = smem + DF_V + (j & 1) * (128 * VT_PITCH);
        if (64 * j <= tmin + 31) {
            if (64 * j + 63 + 128 > tmin) attn_tile2<3, 4>(Ks, Vs, qf, r, h, negm, l, o, t - 64 * j, DF_VN, DF_VD0, true, tabL);
            else attn_tile2<0, 4>(Ks, Vs, qf, r, h, negm, l, o, 0, 1, 0, true, tabL);
        }
        __syncthreads();
    }
#undef DF_DMA
    const float lt = l + __shfl_xor(l, 32);
    const float inv = 1.0f / lt;
    const int tloc = 32 * qs + r;
    if (mp == 1) {
#pragma unroll
        for (int dt = 0; dt < 4; ++dt)
#pragma unroll
            for (int i = 0; i < 16; ++i) o2b[tloc * 129 + 32 * dt + crow(i, h)] = lam * inv * o[dt][i];
    }
    __syncthreads();
    if (mp == 0) {
        float ss = 0.f;
#pragma unroll
        for (int dt = 0; dt < 4; ++dt)
#pragma unroll
            for (int i = 0; i < 16; ++i) { const float v = o[dt][i] * inv - o2b[tloc * 129 + 32 * dt + crow(i, h)]; o[dt][i] = v; ss += v * v; }
        ss += __shfl_xor(ss, 32);
        const float rn = __builtin_amdgcn_rsqf(ss * (1.0f / 128.0f) + RMS_EPS) * 0.8f;
        bf16_t* mpx = (bf16_t*)(P.ws + OFF_H) + tg * DM + 512 + hd * 128;
#pragma unroll
        for (int dt = 0; dt < 4; ++dt)
#pragma unroll
            for (int gi = 0; gi < 4; ++gi) {
                const int d = 32 * dt + 8 * gi + 4 * h;
                const f32x4 gg = *(const f32x4*)(P.subln_g + d);
                f32x4 v = {o[dt][4 * gi] * rn * gg.x, o[dt][4 * gi + 1] * rn * gg.y, o[dt][4 * gi + 2] * rn * gg.z, o[dt][4 * gi + 3] * rn * gg.w};
                st_bf4(mpx + d, v, 1.f);
            }
    }
}

DI void phase_attention(const Params& P, char* smem) {
    float lam;
    {
        const int lane = ltid() & 63;
        const float a = wave_sum(P.lam_q1[lane] * P.lam_k1[lane]);
        const float b2 = wave_sum(P.lam_q2[lane] * P.lam_k2[lane]);
        lam = __expf(a) - __expf(b2) + 0.2f;
    }
    for (int u = blockIdx.x; u < 4096; u += gridDim.x) {
        const int k = u >> 1;
        if (((u + (u >> 8)) & 1) == 0) {
            const int qi = 31 - (k >> 6), bh = k & 63;
#ifndef REP_KIND
#define REP_KIND 0
#endif
            for (int rp = 0; rp < (REP_KIND == 1 ? 2 : 1); ++rp)
            diff_unit(P, smem, bh >> 2, bh & 3, qi, lam);
        } else {
            const int cur = 63 - (k >> 5), bgi = k & 31;
            for (int rp = 0; rp < (REP_KIND == 2 ? 2 : 1); ++rp)
            nsa_unit(P, smem, bgi >> 1, bgi & 1, cur);
        }
    }
}

#define INS16(v, c) do { _Pragma("unroll") for (int e_ = 0; e_ < 16; ++e_) { const unsigned hi_ = (v)[e_] > (c) ? (v)[e_] : (c); (c) = (v)[e_] > (c) ? (c) : (v)[e_]; (v)[e_] = hi_; } } while (0)
constexpr int RT_SK = 0, RT_SCR = 65536, RT_END = RT_SCR + 8 * 2048;

DI void phase_retrieval(const Params& P, char* smem, int task0 = 0, int task1 = 2048 * 8, int bi = blockIdx.x, int nb = gridDim.x) {
    const int tid = ltid(), lane = tid & 63, wid = tid >> 6, r = lane & 31, h = lane >> 5;
    __syncthreads();
    {
        const bf16_t* sk = (const bf16_t*)(P.ws + OFF_SK);
        for (int i = tid; i < 2 * 128 * 16; i += NTHREADS) {
            const int row = i >> 4, c = i & 15;
            *(u32x4*)(smem + RT_SK + row * 256 + ((c ^ (row & 15)) << 4)) = *(const u32x4*)(sk + (size_t)row * 128 + c * 8);
        }
    }
    __syncthreads();
    unsigned char* scr = (unsigned char*)(smem + RT_SCR) + wid * 2048 + lane * 32;
    const int gw = bi * 8 + wid, NGW = nb * 8;
    for (int task = task0 + gw; task < task1; task += NGW) {
        const int tt = task >> 3, hp = task & 7;
        const size_t tok = (size_t)tt * 32 + r;
        unsigned L[2][16];
#pragma unroll
        for (int p = 0; p < 2; ++p) {
            bf16x8 qf[8];
            {
                const bf16_t* qb = (const bf16_t*)(P.ws + OFF_QP) + ((size_t)tt * 16 + hp * 2 + p) * 4096 + (size_t)(h * 32 + r) * 8;
#pragma unroll
                for (int ks = 0; ks < 8; ++ks) qf[ks] = *(const bf16x8*)(qb + ks * 512);
            }
            unsigned v[16];
#pragma unroll
            for (int kt = 0; kt < 4; ++kt) {
                f32x16 acc;
#pragma unroll
                for (int i = 0; i < 16; ++i) acc[i] = 0.f;
                const char* krow = smem + RT_SK + (p * 128 + 32 * kt + r) * 256;
                bf16x8 kf[8];
#pragma unroll
                for (int ks = 0; ks < 8; ++ks) kf[ks] = *(const bf16x8*)(krow + (((2 * ks + h) ^ (r & 15)) << 4));
#pragma unroll
                for (int ks = 0; ks < 8; ++ks) acc = MFMA32(kf[ks], qf[ks], acc);
                unsigned k[16];
#pragma unroll
                for (int i = 0; i < 16; ++i) k[i] = (ord_key(acc[i]) & ~127u) | (unsigned)(127 - (32 * kt + crow(i, h)));
                sort16_desc(k);
                if (kt == 0) {
#pragma unroll
                    for (int e = 0; e < 16; ++e) v[e] = k[e];
                } else merge16_desc(v, k);
            }
            unsigned w2[16];
#pragma unroll
            for (int e = 0; e < 16; ++e) w2[e] = (unsigned)__shfl_xor((int)v[e], 32);
            merge16_desc(v, w2);
#pragma unroll
            for (int e = 0; e < 16; ++e) L[p][e] = v[e];
        }
        float s0[16], s1[16];
#pragma unroll
        for (int e = 0; e < 16; ++e) { s0[e] = unord_key(L[0][e] & ~127u); s1[e] = unord_key(L[1][e] & ~127u); }
        unsigned f[16];
        {
            unsigned ca[16], cb[16];
#pragma unroll
            for (int e = 0; e < 16; ++e) { ca[e] = 0u; cb[e] = 0u; }
            const unsigned hm2 = 0u - (unsigned)h;
            int n = 0;
            unsigned prev = 0u;
#pragma unroll
            for (int a = 0; a < 16; ++a)
#pragma unroll
                for (int bb = 0; bb < 16; ++bb)
                    if ((a + 1) * (bb + 1) <= 16) {
                        const unsigned c = (ord_key(s0[a] + s1[bb]) & ~255u) | (unsigned)(255 - (a * 16 + bb));
                        if (n & 1) { const unsigned sel = prev ^ ((prev ^ c) & hm2); const int m = n >> 1; if (m < 16) ca[m] = sel; else cb[m - 16] = sel; }
                        prev = c;
                        ++n;
                    }
            sort16_desc(ca); sort16_desc(cb);
            merge16_desc(ca, cb);
            unsigned w2[16];
#pragma unroll
            for (int e = 0; e < 16; ++e) w2[e] = (unsigned)__shfl_xor((int)ca[e], 32);
            merge16_desc(ca, w2);
#pragma unroll
            for (int e = 0; e < 16; ++e) f[e] = ca[e];
        }
#pragma unroll
        for (int e = 0; e < 16; e += 4) {
            const unsigned i0 = (127u - (L[0][e] & 127u)) | ((127u - (L[0][e + 1] & 127u)) << 8) | ((127u - (L[0][e + 2] & 127u)) << 16) | ((127u - (L[0][e + 3] & 127u)) << 24);
            const unsigned i1 = (127u - (L[1][e] & 127u)) | ((127u - (L[1][e + 1] & 127u)) << 8) | ((127u - (L[1][e + 2] & 127u)) << 16) | ((127u - (L[1][e + 3] & 127u)) << 24);
            *(unsigned*)(scr + e) = i0; *(unsigned*)(scr + 16 + e) = i1;
        }
        const float best0 = unord_key(f[0] & ~255u);
        float ex[16]; float sum = 0.f;
#pragma unroll
        for (int e = 0; e < 16; ++e) { ex[e] = __expf(unord_key(f[e] & ~255u) - best0); sum += ex[e]; }
        const float inv = 1.0f / sum;
        int* eo = (int*)(P.ws + OFF_EID) + tok * 128 + hp * 16 + 8 * h;
        float* go = (float*)(P.ws + OFF_GW) + tok * 128 + hp * 16 + 8 * h;
        int eid[8]; float gg[8];
        const unsigned hm = 0u - (unsigned)h;
#pragma unroll
        for (int e = 0; e < 8; ++e) {
            const unsigned key = f[e] ^ ((f[e] ^ f[8 + e]) & hm);
            const int pos = 255 - (int)(key & 255u), a = pos >> 4, bb = pos & 15;
            eid[e] = (int)scr[a] * 128 + (int)scr[16 + bb];
            const unsigned xe = __float_as_uint(ex[e]) ^ ((__float_as_uint(ex[e]) ^ __float_as_uint(ex[8 + e])) & hm);
            gg[e] = __uint_as_float(xe) * inv;
        }
        *(int4*)(eo) = make_int4(eid[0], eid[1], eid[2], eid[3]); *(int4*)(eo + 4) = make_int4(eid[4], eid[5], eid[6], eid[7]);
        *(f32x4*)(go) = (f32x4){gg[0], gg[1], gg[2], gg[3]}; *(f32x4*)(go + 4) = (f32x4){gg[4], gg[5], gg[6], gg[7]};
    }
}

DI float ub0(unsigned w) { return (float)(w & 0xffu); }
DI float ub1(unsigned w) { return (float)((w >> 8) & 0xffu); }
DI float ub2(unsigned w) { return (float)((w >> 16) & 0xffu); }
DI float ub3(unsigned w) { return (float)(w >> 24); }

typedef _Float16 h16x2_t __attribute__((ext_vector_type(2)));
DI float dot2h(unsigned a, unsigned b, float c) { return __builtin_amdgcn_fdot2(__builtin_bit_cast(h16x2_t, a), __builtin_bit_cast(h16x2_t, b), c, false); }
DI float dot16_u8(const unsigned (&hp)[8], u32x4 w) {
    float a = dot2h(hp[0], __builtin_amdgcn_perm(0x64646464u, w.x, 0x04010400u), 0.f);
    a = dot2h(hp[1], __builtin_amdgcn_perm(0x64646464u, w.x, 0x04030402u), a);
    a = dot2h(hp[2], __builtin_amdgcn_perm(0x64646464u, w.y, 0x04010400u), a);
    a = dot2h(hp[3], __builtin_amdgcn_perm(0x64646464u, w.y, 0x04030402u), a);
    a = dot2h(hp[4], __builtin_amdgcn_perm(0x64646464u, w.z, 0x04010400u), a);
    a = dot2h(hp[5], __builtin_amdgcn_perm(0x64646464u, w.z, 0x04030402u), a);
    a = dot2h(hp[6], __builtin_amdgcn_perm(0x64646464u, w.w, 0x04010400u), a);
    a = dot2h(hp[7], __builtin_amdgcn_perm(0x64646464u, w.w, 0x04030402u), a);
    return a;
}
DI void phase_experts(const Params& P, int row0 = 0, int row1 = NTOK, int bi = blockIdx.x, int nb = gridDim.x) {
    const int tid = ltid(), lane = tid & 63, wid = tid >> 6;
    const int gw = bi * 8 + wid, NGW = nb * 8;
    const unsigned char* U = P.ws + OFF_U;
    const unsigned char* V = P.ws + OFF_V;
    const float* US = (const float*)(P.ws + OFF_US);
    const float* VS = (const float*)(P.ws + OFF_VS);
    const float* mod = (const float*)(P.ws + OFF_MOD);
    for (int row = row0 + gw; row < row1; row += NGW) {
        const int b = row >> 12;
        const bf16_t* hrow = (const bf16_t*)(P.ws + OFF_H) + (size_t)row * DM + 16 * lane;
        unsigned hq[8]; float hs = 0.f;
        {
            const u32x4 h0 = *(const u32x4*)(hrow), h1 = *(const u32x4*)(hrow + 8);
            const unsigned hw[8] = {h0.x, h0.y, h0.z, h0.w, h1.x, h1.y, h1.z, h1.w};
#pragma unroll
            for (int i = 0; i < 8; ++i) {
                const _Float16 a = (_Float16)bf_lo(hw[i]), b2 = (_Float16)bf_hi(hw[i]);
                hs += (float)a + (float)b2;
                h16x2_t pv = {a, b2};
                hq[i] = __builtin_bit_cast(unsigned, pv);
            }
        }
        const float hsum128 = 1152.0f * wave_sum(hs);
        float out[16];
#pragma unroll
        for (int i = 0; i < 16; ++i) out[i] = 0.f;
        float csum = 0.f;
        const int* eidp = (const int*)(P.ws + OFF_EID) + (size_t)row * 128;
        const float* gwp = (const float*)(P.ws + OFF_GW) + (size_t)row * 128;
        for (int hp = 0; hp < 8; ++hp) {
            const int eme = eidp[hp * 16 + (lane & 15)];
            const float gme = gwp[hp * 16 + (lane & 15)];
            const float sume = US[eme], svme = VS[eme];
            int eid[16];
#pragma unroll
            for (int e = 0; e < 16; ++e) eid[e] = __builtin_amdgcn_readlane(eme, e);
            float part[16];
            {
                u32x4 uw[16];
#pragma unroll
                for (int e = 0; e < 16; ++e) uw[e] = *(const u32x4*)(U + (size_t)eid[e] * DM + 16 * lane);
#pragma unroll
                for (int e = 0; e < 16; ++e) part[e] = dot16_u8(hq, uw[e]);
            }
            u32x4 vw[16];
#pragma unroll
            for (int e = 0; e < 16; ++e) vw[e] = *(const u32x4*)(V + (size_t)eid[e] * DM + 16 * lane);
            float q8[8], q4[4], q2[2], q1;
            {
                const bool up = (lane & 32) != 0;
#pragma unroll
                for (int i = 0; i < 8; ++i) { const float send = up ? part[i] : part[i + 8], keep = up ? part[i + 8] : part[i]; q8[i] = keep + __shfl_xor(send, 32); }
            }
            {
                const bool up = (lane & 16) != 0;
#pragma unroll
                for (int i = 0; i < 4; ++i) { const float send = up ? q8[i] : q8[i + 4], keep = up ? q8[i + 4] : q8[i]; q4[i] = keep + __shfl_xor(send, 16); }
            }
            {
                const bool up = (lane & 8) != 0;
#pragma unroll
                for (int i = 0; i < 2; ++i) { const float send = up ? q4[i] : q4[i + 2], keep = up ? q4[i + 2] : q4[i]; q2[i] = keep + __shfl_xor(send, 8); }
            }
            {
                const bool up = (lane & 4) != 0;
                const float send = up ? q2[0] : q2[1], keep = up ? q2[1] : q2[0];
                q1 = keep + __shfl_xor(send, 4);
            }
            q1 += __shfl_xor(q1, 2);
            q1 += __shfl_xor(q1, 1);
            const int emine = ((lane >> 5) & 1) * 8 + ((lane >> 4) & 1) * 4 + ((lane >> 3) & 1) * 2 + ((lane >> 2) & 1);
            const float gmine = __shfl(gme, emine), sumine = __shfl(sume, emine), svmine = __shfl(svme, emine);
            const float coef = gmine * gelu_tanh(sumine * (q1 - hsum128)) * svmine;
#pragma unroll
            for (int e = 0; e < 16; ++e) {
                const int src = ((e >> 3) & 1) * 32 + ((e >> 2) & 1) * 16 + ((e >> 1) & 1) * 8 + (e & 1) * 4;
                const float ce = __builtin_bit_cast(float, __builtin_amdgcn_readlane(__builtin_bit_cast(int, coef), src));
                csum += ce;
                out[0] += ce * ub0(vw[e].x); out[1] += ce * ub1(vw[e].x); out[2] += ce * ub2(vw[e].x); out[3] += ce * ub3(vw[e].x);
                out[4] += ce * ub0(vw[e].y); out[5] += ce * ub1(vw[e].y); out[6] += ce * ub2(vw[e].y); out[7] += ce * ub3(vw[e].y);
                out[8] += ce * ub0(vw[e].z); out[9] += ce * ub1(vw[e].z); out[10] += ce * ub2(vw[e].z); out[11] += ce * ub3(vw[e].z);
                out[12] += ce * ub0(vw[e].w); out[13] += ce * ub1(vw[e].w); out[14] += ce * ub2(vw[e].w); out[15] += ce * ub3(vw[e].w);
            }
        }
        const float cb = 128.0f * csum;
        const bf16_t* x1r = (const bf16_t*)(P.ws + OFF_X1) + (size_t)row * DM + 16 * lane;
        const u32x4 xa = *(const u32x4*)(x1r), xb = *(const u32x4*)(x1r + 8);
        const float x1f[16] = {bf_lo(xa.x), bf_hi(xa.x), bf_lo(xa.y), bf_hi(xa.y), bf_lo(xa.z), bf_hi(xa.z), bf_lo(xa.w), bf_hi(xa.w),
                               bf_lo(xb.x), bf_hi(xb.x), bf_lo(xb.y), bf_hi(xb.y), bf_lo(xb.z), bf_hi(xb.z), bf_lo(xb.w), bf_hi(xb.w)};
        const float* gf = mod + (size_t)b * 6144 + 5 * 1024 + 16 * lane;
        float x2[16]; float ss = 0.f;
#pragma unroll
        for (int q = 0; q < 4; ++q) {
            const f32x4 xv = {x1f[4 * q], x1f[4 * q + 1], x1f[4 * q + 2], x1f[4 * q + 3]}, g = *(const f32x4*)(gf + 4 * q);
            const int o = 4 * q;
            x2[o] = xv.x + g.x * (out[o] - cb); x2[o + 1] = xv.y + g.y * (out[o + 1] - cb); x2[o + 2] = xv.z + g.z * (out[o + 2] - cb); x2[o + 3] = xv.w + g.w * (out[o + 3] - cb);
            ss += (x2[o] * x2[o] + x2[o + 1] * x2[o + 1]) + (x2[o + 2] * x2[o + 2] + x2[o + 3] * x2[o + 3]);
        }
        const float rstd = __builtin_amdgcn_rsqf(wave_sum(ss) * (1.0f / DM) + RMS_EPS);
        float* orow = P.out + (size_t)row * DM + 16 * lane;
#pragma unroll
        for (int q = 0; q < 4; ++q) {
            const int o = 4 * q;
            const f32x4 g = *(const f32x4*)(P.final_g + 16 * lane + 4 * q);
            *(f32x4*)(orow + 4 * q) = (f32x4){x2[o] * rstd * g.x, x2[o + 1] * rstd * g.y, x2[o + 2] * rstd * g.z, x2[o + 3] * rstd * g.w};
        }
    }
}

#define XB_TMO      128
#define XB_XCNT(j)  (256  + 64 * (j))
#define XB_XSUB(j)  (1280 + 64 * (j))
#define XB_XGEN(j)  (2304 + 64 * (j))
#define XB_TOP      3328
#define XB_TOPGEN   3392
#define XCD_BAR_WORDS 3456
#define XB_SPIN_CAP (1u << 18)

__device__ __forceinline__ unsigned xb_ld(unsigned* p)              { return __hip_atomic_load(p, __ATOMIC_RELAXED, __HIP_MEMORY_SCOPE_AGENT); }
__device__ __forceinline__ unsigned xb_add(unsigned* p, unsigned v) { return __hip_atomic_fetch_add(p, v, __ATOMIC_RELAXED, __HIP_MEMORY_SCOPE_AGENT); }
__device__ __forceinline__ unsigned xb_xcc_id() { return (unsigned)__builtin_amdgcn_s_getreg((3 << 11) | 20) & 0xFu; }
#define XB_SPIN(cond, bar) do { unsigned _sp = 0; while (cond) { __builtin_amdgcn_s_sleep(1); \
    if ((++_sp & 255u) == 0u) { if (xb_ld(&(bar)[XB_TMO])) break; if (_sp > XB_SPIN_CAP) { atomicAdd(&(bar)[XB_TMO], 1u); break; } } } } while (0)

struct XcdBarrier {
    unsigned* bar; unsigned x;
    volatile LAS3 unsigned* st;
};

__device__ __forceinline__ XcdBarrier xcd_barrier_post(unsigned* bar, volatile LAS3 unsigned* st) {
    XcdBarrier b; b.bar = bar; b.x = xb_xcc_id(); b.st = st;
    if (threadIdx.x == 0) (void)xb_add(&bar[XB_XCNT(b.x)], 1u);
    return b;
}
__device__ __forceinline__ void xcd_barrier_complete(unsigned* bar, unsigned x, unsigned& nloc, unsigned& nx) {
    const unsigned G = gridDim.x * gridDim.y * gridDim.z;
    unsigned sum, cnt, mine, sp = 0u;
    for (;;) {
        sum = 0u; cnt = 0u; mine = 0u;
#pragma unroll
        for (unsigned j = 0; j < 16; ++j) { const unsigned c = xb_ld(&bar[XB_XCNT(j)]); sum += c; cnt += (c > 0u) ? 1u : 0u; mine = (j == x) ? c : mine; }
        if (sum == G) break;
        __builtin_amdgcn_s_sleep(1);
        if ((++sp & 255u) == 0u) { if (xb_ld(&bar[XB_TMO])) break; if (sp > XB_SPIN_CAP) { atomicAdd(&bar[XB_TMO], 1u); break; } }
    }
    nloc = mine > 0u ? mine : 1u; nx = cnt > 0u ? cnt : 1u;
}

__device__ __forceinline__ void xcd_barrier(const XcdBarrier& b) {
    asm volatile("s_waitcnt vmcnt(0)" ::: "memory");
    __syncthreads();
    if (threadIdx.x == 0) {
        unsigned* bar = b.bar;
        __builtin_amdgcn_s_waitcnt(0);
        unsigned nloc = b.st[0], nx = b.st[1];
        if (nloc == 0u) { xcd_barrier_complete(bar, b.x, nloc, nx); b.st[0] = nloc; b.st[1] = nx; }
        const unsigned old = xb_add(&bar[XB_XSUB(b.x)], 1u);
        const unsigned gen = old / nloc;
        if (old + 1u == (gen + 1u) * nloc) {
            __builtin_amdgcn_fence(__ATOMIC_RELEASE, "agent");
            asm volatile("s_waitcnt vmcnt(0)" ::: "memory");
            const unsigned og = xb_add(&bar[XB_TOP], 1u);
            const unsigned tg = og / nx;
            if (og + 1u == (tg + 1u) * nx) xb_add(&bar[XB_TOPGEN], 1u);
            else XB_SPIN(xb_ld(&bar[XB_TOPGEN]) == tg, bar);
            __builtin_amdgcn_fence(__ATOMIC_ACQUIRE, "agent");
            xb_add(&bar[XB_XGEN(b.x)], 1u);
            asm volatile("s_waitcnt vmcnt(0)" ::: "memory");
        } else {
            XB_SPIN(xb_ld(&bar[XB_XGEN(b.x)]) == gen, bar);
            __builtin_amdgcn_fence(__ATOMIC_ACQUIRE, "agent");
            asm volatile("s_waitcnt vmcnt(0)" ::: "memory");
        }
    }
    __syncthreads();
}


#define XB_GRP 3520
__device__ __forceinline__ void group_barrier(unsigned* bar, unsigned members, unsigned& target) {
    asm volatile("s_waitcnt vmcnt(0)" ::: "memory");
    __syncthreads();
    target += members;
    if (threadIdx.x == 0) {
        __builtin_amdgcn_s_waitcnt(0);
        __builtin_amdgcn_fence(__ATOMIC_RELEASE, "agent");
        asm volatile("s_waitcnt vmcnt(0)" ::: "memory");
        (void)xb_add(&bar[XB_GRP], 1u);
        XB_SPIN(xb_ld(&bar[XB_GRP]) < target, bar);
        __builtin_amdgcn_fence(__ATOMIC_ACQUIRE, "agent");
        asm volatile("s_waitcnt vmcnt(0)" ::: "memory");
    }
    __syncthreads();
}

constexpr int N_PHASES = 11;
__global__ void __launch_bounds__(NTHREADS) fwd_kernel(Params P) {
    extern __shared__ __attribute__((aligned(16))) char smem[];
    cg::grid_group grid = cg::this_grid();
    const int lo = P.ph_lo, hi = P.ph_hi;
    const int G = gridDim.x, bid = blockIdx.x;
#ifndef REP_PHASE
#define REP_PHASE -1
#endif
#define IN(k) (lo <= (k) && (k) < hi)
#define REPS(k) for (int rep_ = 0; rep_ < ((k) == REP_PHASE ? 2 : 1); ++rep_)
    volatile LAS3 unsigned* bst = (volatile LAS3 unsigned*)((LAS3 char*)smem + (LDS_BYTES - 16));
    if (threadIdx.x < 2) bst[threadIdx.x] = 0u;
    __syncthreads();
    XcdBarrier xbar = xcd_barrier_post((unsigned*)(P.ws + OFF_BAR), bst);
    if (lo > 1000) grid.sync();
#define SEAM(k) do { if (IN(k) && IN((k) + 1)) xcd_barrier(xbar); } while (0)
    const bool defer_late = G > 128 && lo == 0 && hi > 3;
    REPS(0) if (IN(0)) { if (defer_late) phase_prologue<0>(P, smem, bid, G); else phase_prologue<2>(P, smem, bid, G); }
    SEAM(0);
    REPS(1) if (IN(1)) phase_normmod<false>(P, P.x, P.norm1_g, 0, 1, (bf16_t*)(P.ws + OFF_H));
    SEAM(1);
    REPS(2) if (IN(2)) {
        {
            const pg8::Gemm g{(const bf16_t*)(P.ws + OFF_H), (const bf16_t*)(P.ws + OFF_WINT), NTOK, 2304, DM};
            pg8::StaticOrder S; S.init(NTOK, 2304, G, bid);
            const EpiPg8<EpiInProj> E{EpiInProj{P.ws}};
            pg8::gemm_phase<EpiPg8<EpiInProj>, pg8::StaticOrder, true, true>((PG8_LAS unsigned char*)smem, g, S, E);
        }
        {
            const pg8::Gemm g{(const bf16_t*)(P.ws + OFF_WINT) + (size_t)2304 * DM, (const bf16_t*)(P.ws + OFF_H), 768, NTOK, DM};
            pg8::StaticOrder S; S.init(768, NTOK, G, bid);
            const EpiPg8<EpiInProjT> E{EpiInProjT{P.ws}};
            pg8::gemm_phase<EpiPg8<EpiInProjT>, pg8::StaticOrder, true, true>((PG8_LAS unsigned char*)smem, g, S, E);
        }
    }
    SEAM(2);
    REPS(3) if (IN(3)) {
        if (defer_late && bid >= 128) phase_prologue<1>(P, smem, bid - 128, G - 128);
        for (int u = bid; u < 2 * 32 * 2; u += (defer_late ? 128 : G)) {
            if (defer_late && bid >= 128) break;
            const int kv = u >> 6, mt = (u >> 1) & 31, nt = u & 1;
            const ACmp af{(const bf16_t*)(P.ws + (kv ? OFF_VC : OFF_KC))};
            const EpiCmp1 epi{(bf16_t*)(P.ws + OFF_HID) + (size_t)kv * 8192 * 256, (const float*)(P.ws + OFF_PB) + kv * 256};
            gemm_tile<false>(smem, af, (const bf16_t*)(P.ws + OFF_W1T) + (size_t)kv * 256 * 2048, 2048, mt * 256, nt * 128, 32, epi);
        }
    }
    SEAM(3);
    REPS(4) if (IN(4)) {
        for (int u = bid; u < 2 * 32; u += G) {
            const int kv = u >> 5, mt = u & 31;
            const ARowMajor af{(const bf16_t*)(P.ws + OFF_HID) + (size_t)kv * 8192 * 256, 256};
            const EpiCmp2 epi{(bf16_t*)(P.ws + OFF_KCMP), (bf16_t*)(P.ws + OFF_VCMPT)};
            const bf16_t* Bt = (const bf16_t*)(P.ws + OFF_W2T) + (size_t)kv * 128 * 256;
            if (kv) gemm_tile<true>(smem, af, Bt, 256, mt * 256, 0, 4, epi);
            else gemm_tile<false>(smem, af, Bt, 256, mt * 256, 0, 4, epi);
        }
    }
    SEAM(4);
    REPS(5) if (IN(5)) phase_attention(P, smem);
    SEAM(5);
    REPS(6) if (IN(6)) {
        const pg8::Gemm g{(const bf16_t*)(P.ws + OFF_H), (const bf16_t*)(P.ws + OFF_WOUTT), NTOK, DM, DM};
        pg8::StaticOrder S; S.init(NTOK, DM, G, bid);
        const EpiPg8<EpiOutProj> E{EpiOutProj{P.x, (const float*)(P.ws + OFF_MOD), (bf16_t*)(P.ws + OFF_X1)}};
        pg8::gemm_phase<EpiPg8<EpiOutProj>, pg8::StaticOrder, true, true>((PG8_LAS unsigned char*)smem, g, S, E);
    }
    SEAM(6);
    if (IN(7)) {
        constexpr int NCH = 3;
        constexpr int TB[NCH + 1] = {0, 64 * 256, 152 * 256, NTOK};
        const int PIPE_X = G >= 128 ? G / 4 : 0;
        unsigned gtarget = 0u;
        for (int k = 0; k <= NCH; ++k) {
            const bool hasX = k < NCH, hasE = k >= 1;
            const bool mixed = hasX && hasE && PIPE_X > 0;
            if (!mixed && hasE) phase_experts(P, TB[k - 1], TB[k], bid, G);
            if (mixed && bid < G - PIPE_X) phase_experts(P, TB[k - 1], TB[k], bid, G - PIPE_X);
            if (hasX && (!mixed || bid >= G - PIPE_X)) {
                const int bi = mixed ? bid - (G - PIPE_X) : bid, nb = mixed ? PIPE_X : G;
                const int r0 = TB[k], r1 = TB[k + 1];
                phase_normmod<true>(P, P.ws + OFF_X1, P.norm2_g, 3, 4, (bf16_t*)(P.ws + OFF_H), r0, r1, bi, nb);
                if (mixed) group_barrier((unsigned*)(P.ws + OFF_BAR), (unsigned)PIPE_X, gtarget); else xcd_barrier(xbar);
                {
                    const pg8::Gemm g{(const bf16_t*)(P.ws + OFF_H) + (size_t)r0 * DM, (const bf16_t*)(P.ws + OFF_WQT), r1 - r0, 2048, DM};
                    pg8::StaticOrder S; S.init(r1 - r0, 2048, nb, bi);
                    const EpiPg8<EpiWq> E{EpiWq{(bf16_t*)(P.ws + OFF_QP) + (size_t)(r0 >> 5) * 16 * 4096}};
                    pg8::gemm_phase<EpiPg8<EpiWq>, pg8::StaticOrder, true, true>((PG8_LAS unsigned char*)smem, g, S, E);
                }
                if (mixed) group_barrier((unsigned*)(P.ws + OFF_BAR), (unsigned)PIPE_X, gtarget); else xcd_barrier(xbar);
                phase_retrieval(P, smem, (r0 >> 5) * 8, (r1 >> 5) * 8, bi, nb);
            }
            if (k < NCH) xcd_barrier(xbar);
        }
    }
#undef IN
#undef SEAM
}

extern "C" void kernel_launch(void* const* d_in, const int* in_sizes, int n_in, void* d_out, int out_size, void* d_ws, size_t ws_size, hipStream_t stream) {
    static int grid = 0;
    if (grid == 0) {
        if (n_in != 22 || in_sizes[0] != NTOK * DM || out_size != NTOK * DM || ws_size < WS_NEED) {
            fprintf(stderr, "kernel_launch: unexpected shapes (n_in %d, in0 %d, out %d, ws %zu); nothing launched\n", n_in, n_in > 0 ? in_sizes[0] : -1, out_size, ws_size);
            grid = -1; return;
        }
        int dev = 0, cus = 0, per_cu = 0;
        (void)hipGetDevice(&dev);
        (void)hipDeviceGetAttribute(&cus, hipDeviceAttributeMultiprocessorCount, dev);
        if (hipFuncSetAttribute((const void*)fwd_kernel, hipFuncAttributeMaxDynamicSharedMemorySize, LDS_BYTES) != hipSuccess) { fprintf(stderr, "kernel_launch: hipFuncSetAttribute failed\n"); grid = -1; return; }
        if (hipOccupancyMaxActiveBlocksPerMultiprocessor(&per_cu, (const void*)fwd_kernel, NTHREADS, LDS_BYTES) != hipSuccess || per_cu < 1) { fprintf(stderr, "kernel_launch: occupancy query failed (%d)\n", per_cu); (void)hipGetLastError(); per_cu = 1; }
        if (per_cu > 1) per_cu = 1;
        grid = cus * per_cu;
        if (grid <= 0) grid = 256;
    }
    if (grid < 0) return;
    if (hipMemsetAsync((char*)d_ws + OFF_BAR, 0, 16384, stream) != hipSuccess) { fprintf(stderr, "kernel_launch: hipMemsetAsync failed\n"); return; }
    Params p{};
    const float** pp = (const float**)&p;
    for (int i = 0; i < 22; ++i) pp[i] = (const float*)d_in[i];
    p.out = (float*)d_out; p.ws = (unsigned char*)d_ws;
#if MK_SPLIT
    for (int ph = 0; ph < N_PHASES; ++ph) {
        p.ph_lo = ph; p.ph_hi = ph + 1;
        void* args[] = {&p};
        hipError_t e = hipLaunchCooperativeKernel((const void*)fwd_kernel, dim3(grid), dim3(NTHREADS), args, LDS_BYTES, stream);
        if (e != hipSuccess) { fprintf(stderr, "kernel_launch: launch of phase %d failed: %s\n", ph, hipGetErrorString(e)); break; }
    }
#else
    p.ph_lo = 0; p.ph_hi = N_PHASES;
    void* args[] = {&p};
    hipError_t e = hipLaunchCooperativeKernel((const void*)fwd_kernel, dim3(grid), dim3(NTHREADS), args, LDS_BYTES, stream);
    if (e != hipSuccess) fprintf(stderr, "kernel_launch: cooperative launch failed: %s (grid %d)\n", hipGetErrorString(e), grid);
#endif
}
```

```cpp
#include <hip/hip_runtime.h>
#include <hip/hip_cooperative_groups.h>
#include <cstdio>
#include <cstdint>
namespace cg = cooperative_groups;

#ifndef MK_SPLIT
#define MK_SPLIT 0
#endif

#define DI __device__ __forceinline__
typedef unsigned short bf16_t;
typedef short bf16x8 __attribute__((ext_vector_type(8)));
typedef short s16x4 __attribute__((ext_vector_type(4)));
typedef float f32x4 __attribute__((ext_vector_type(4)));
typedef float f32x16 __attribute__((ext_vector_type(16)));
typedef unsigned u32x4 __attribute__((ext_vector_type(4)));
typedef unsigned u32x2 __attribute__((ext_vector_type(2)));
typedef __bf16 bf16x2_t __attribute__((ext_vector_type(2)));
typedef float f32x2_t __attribute__((ext_vector_type(2)));

#define MFMA32(a, b, c) __builtin_amdgcn_mfma_f32_32x32x16_bf16((a), (b), (c), 0, 0, 0)
#define MFMA16(a, b, c) __builtin_amdgcn_mfma_f32_16x16x32_bf16((a), (b), (c), 0, 0, 0)

constexpr int NB = 16, SEQ = 4096, DM = 1024, NTOK = NB * SEQ;
constexpr int NIN_PAD = 2944;
constexpr int NTHREADS = 512;
constexpr float LOG2E = 1.4426950408889634f;
constexpr float QSCALE = 0.125f * LOG2E;
constexpr float NEGB = -1e30f;
constexpr float RMS_EPS = 1e-6f;
constexpr int LDS_BYTES = 163840;

constexpr size_t MiB = 1u << 20;
constexpr size_t OFF_MOD = 0, OFF_TAB = 512 * 1024, OFF_PB = 520 * 1024, OFF_BAR = 768 * 1024;
constexpr size_t OFF_SK = 1 * MiB, OFF_W2T = 1 * MiB + 128 * 1024;
constexpr size_t OFF_W1T = 2 * MiB, OFF_WOUTT = 4 * MiB, OFF_WQT = 6 * MiB, OFF_WINT = 10 * MiB;
constexpr size_t OFF_HID = 16 * MiB, OFF_KCMP = 24 * MiB, OFF_VCMPT = 25 * MiB;
constexpr size_t OFF_U = 32 * MiB, OFF_V = 64 * MiB;
constexpr size_t OFF_US = 48 * MiB, OFF_VS = 80 * MiB;
constexpr size_t OFF_H = 96 * MiB;
constexpr size_t OFF_X1 = 224 * MiB;
constexpr size_t OFF_EID = 480 * MiB, OFF_GW = 512 * MiB;
constexpr size_t OFF_PROJ = 544 * MiB;
constexpr size_t OFF_QN = OFF_PROJ, OFF_KC = OFF_PROJ + 64 * MiB, OFF_VC = OFF_PROJ + 80 * MiB, OFF_KS = OFF_PROJ + 96 * MiB,
                 OFF_VST = OFF_PROJ + 112 * MiB, OFF_KW = OFF_PROJ + 128 * MiB, OFF_VWT = OFF_PROJ + 144 * MiB,
                 OFF_GATES = OFF_PROJ + 160 * MiB, OFF_DQ = OFF_PROJ + 168 * MiB, OFF_DK = OFF_PROJ + 232 * MiB,
                 OFF_DVT = OFF_PROJ + 296 * MiB;
constexpr size_t OFF_QP = OFF_PROJ;
constexpr size_t OFF_CO = 904 * MiB;
constexpr size_t WS_NEED = 936 * MiB;

struct Params {
    const float *x, *c, *rel_bias, *ada_w, *ada_b, *norm1_g, *norm2_g, *w_in, *w_out, *cmp_pos, *cmp_w1, *cmp_w2,
                *lam_q1, *lam_k1, *lam_q2, *lam_k2, *subln_g, *peer_wq, *peer_sub, *peer_u, *peer_v, *final_g;
    float* out;
    unsigned char* ws;
    int ph_lo, ph_hi;
};

DI unsigned pk2(float lo, float hi) { f32x2_t v = {lo, hi}; bf16x2_t b = __builtin_convertvector(v, bf16x2_t); return __builtin_bit_cast(unsigned, b); }
DI float bf_lo(unsigned w) { return __uint_as_float(w << 16); }
DI float bf_hi(unsigned w) { return __uint_as_float(w & 0xffff0000u); }
DI float wave_sum(float v) {
#pragma unroll
    for (int o = 1; o < 64; o <<= 1) v += __shfl_xor(v, o);
    return v;
}
DI float gelu_tanh(float x) {
    const float u = 0.7978845608028654f * (x + 0.044715f * x * x * x);
    const float e = __builtin_amdgcn_exp2f(-2.0f * LOG2E * u);
    const float th = (1.0f - e) / (1.0f + e);
    return 0.5f * x * (1.0f + th);
}
DI int ltid() { int t = threadIdx.x; asm volatile("" : "+v"(t)); return t; }
DI int crow(int reg, int h) { return (reg & 3) + 8 * (reg >> 2) + 4 * h; }
DI int t5_bucket(int d) {
    if (d < 16) return d;
    int b = 16;
    b += (d >= 19); b += (d >= 21); b += (d >= 24); b += (d >= 27); b += (d >= 31); b += (d >= 35); b += (d >= 40); b += (d >= 46);
    b += (d >= 52); b += (d >= 59); b += (d >= 67); b += (d >= 77); b += (d >= 87); b += (d >= 99); b += (d >= 113);
    return b;
}
DI int perm_in(int n) {
    if (n < 896) return n;
    if (n < 1024) return 2304 + (n - 896);
    if (n < 1152) return 896 + (n - 1024);
    if (n < 1280) return 2432 + (n - 1152);
    if (n < 1304) return 2048 + (n - 1280);
    if (n < 1816) return 1024 + (n - 1304);
    if (n < 2328) return 1536 + (n - 1816);
    return 2560 + (n - 2328);
}

DI void transpose_unit(char* smem, const float* __restrict__ W, int K, int N, bf16_t* __restrict__ Wt, int kb, int nb, int mode) {
    float* tile = (float*)smem;
    const int tid = ltid();
#pragma unroll
    for (int it = 0; it < 8; ++it) {
        const int i = (tid >> 6) + 8 * it, j = tid & 63, n = nb * 64 + j;
        tile[i * 65 + j] = (n < N) ? W[(size_t)(kb * 64 + i) * N + n] : 0.f;
    }
    __syncthreads();
    {
        const int j = tid >> 3, kc = tid & 7, n = nb * 64 + j;
        if (n < N) {
            const int np = mode == 1 ? perm_in(n) : n;
            u32x4 o;
            o.x = pk2(tile[(kc * 8 + 0) * 65 + j], tile[(kc * 8 + 1) * 65 + j]);
            o.y = pk2(tile[(kc * 8 + 2) * 65 + j], tile[(kc * 8 + 3) * 65 + j]);
            o.z = pk2(tile[(kc * 8 + 4) * 65 + j], tile[(kc * 8 + 5) * 65 + j]);
            o.w = pk2(tile[(kc * 8 + 6) * 65 + j], tile[(kc * 8 + 7) * 65 + j]);
            *(u32x4*)(Wt + (size_t)np * K + kb * 64 + kc * 8) = o;
        }
    }
    __syncthreads();
}

DI void mod_unit(char* smem, const Params& P, int u) {
    float* cond = (float*)smem;
    const int tid = ltid();
    for (int i = tid; i < NB * DM; i += NTHREADS) {
        const int b = i >> 10, k = i & 1023;
        const float cv = P.c[i];
        cond[k * 16 + b] = cv / (1.0f + __expf(-cv));
    }
    __syncthreads();
    const int col = u * NTHREADS + tid;
    float acc[16];
#pragma unroll
    for (int b = 0; b < 16; ++b) acc[b] = 0.f;
    const float* wp = P.ada_w + col;
    for (int k0 = 0; k0 < DM; k0 += 16) {
        float wv[16];
#pragma unroll
        for (int i = 0; i < 16; ++i) wv[i] = wp[(size_t)(k0 + i) * 6144];
#pragma unroll
        for (int i = 0; i < 16; ++i) {
        const int k = k0 + i;
        const float w = wv[i];
        const f32x4 c0 = *(const f32x4*)(cond + k * 16), c1 = *(const f32x4*)(cond + k * 16 + 4), c2 = *(const f32x4*)(cond + k * 16 + 8), c3 = *(const f32x4*)(cond + k * 16 + 12);
        acc[0] += w * c0.x; acc[1] += w * c0.y; acc[2] += w * c0.z; acc[3] += w * c0.w;
        acc[4] += w * c1.x; acc[5] += w * c1.y; acc[6] += w * c1.z; acc[7] += w * c1.w;
        acc[8] += w * c2.x; acc[9] += w * c2.y; acc[10] += w * c2.z; acc[11] += w * c2.w;
        acc[12] += w * c3.x; acc[13] += w * c3.y; acc[14] += w * c3.z; acc[15] += w * c3.w;
        }
    }
    float* mod = (float*)(P.ws + OFF_MOD);
    const float bias = P.ada_b[col];
#pragma unroll
    for (int b = 0; b < 16; ++b) mod[(size_t)b * 6144 + col] = acc[b] + bias;
    __syncthreads();
}

DI void misc_unit(const Params& P) {
    const int tid = ltid();
    float* tab = (float*)(P.ws + OFF_TAB);
    for (int i = tid; i < 12 * 128; i += NTHREADS) {
        const int hd = i >> 7, d = i & 127;
        tab[i] = (P.rel_bias[t5_bucket(d) * 12 + hd] - P.rel_bias[31 * 12 + hd]) * LOG2E;
    }
    bf16_t* sk = (bf16_t*)(P.ws + OFF_SK);
    for (int i = tid; i < 2 * 128 * 128 / 2; i += NTHREADS) ((unsigned*)sk)[i] = pk2(P.peer_sub[2 * i], P.peer_sub[2 * i + 1]);
    unsigned* wz = (unsigned*)((bf16_t*)(P.ws + OFF_WINT) + (size_t)2072 * 1024);
    for (int i = tid; i < 232 * 1024 / 2; i += NTHREADS) wz[i] = 0u;
    for (int kv = 0; kv < 2; ++kv) {
        unsigned* z2 = (unsigned*)((bf16_t*)(P.ws + OFF_W2T) + (size_t)(kv * 128 + 64) * 256);
        for (int i = tid; i < 64 * 256 / 2; i += NTHREADS) z2[i] = 0u;
    }
}

DI void pb_unit(char* smem, const Params& P, int u) {
    const int tid = ltid(), o = u * 64 + (tid & 63), kp = tid >> 6;
    const int kv = o >> 8, n = o & 255;
    const float* pos = P.cmp_pos + kv * 2048 + kp * 256;
    const float* w1 = P.cmp_w1 + (size_t)kv * 2048 * 256 + (size_t)kp * 256 * 256 + n;
    float a = 0.f;
    for (int k0 = 0; k0 < 256; k0 += 16) {
        float wv[16];
#pragma unroll
        for (int i = 0; i < 16; ++i) wv[i] = w1[(size_t)(k0 + i) * 256];
#pragma unroll
        for (int i = 0; i < 16; ++i) a += pos[k0 + i] * wv[i];
    }
    float* red = (float*)smem;
    __syncthreads();
    red[kp * 64 + (tid & 63)] = a;
    __syncthreads();
    if (tid < 64) {
        float t = 0.f;
#pragma unroll
        for (int q = 0; q < 8; ++q) t += red[q * 64 + tid];
        ((float*)(P.ws + OFF_PB))[o] = t;
    }
    __syncthreads();
}

template <int PART>
DI void phase_prologue(const Params& P, char* smem, int bidv, int Gv) {
    const int tid = ltid(), G = Gv, bid = bidv;
    if (PART != 0) {
        const int lane = tid & 63, wid = tid >> 6;
        for (int rw0 = (bid * 8 + wid) * 4; rw0 < 2 * 16384; rw0 += G * 8 * 4) {
            f32x4 v[4][4];
#pragma unroll
            for (int q = 0; q < 4; ++q) {
                const int rw = rw0 + q, tb = rw >> 14, e = rw & 16383;
                const float* src = (tb ? P.peer_v : P.peer_u) + (size_t)e * DM + 16 * lane;
#pragma unroll
                for (int j = 0; j < 4; ++j) v[q][j] = *(const f32x4*)(src + 4 * j);
            }
#pragma unroll
            for (int q = 0; q < 4; ++q) {
                const int rw = rw0 + q, tb = rw >> 14, e = rw & 16383;
                float am = 0.f;
#pragma unroll
                for (int j = 0; j < 4; ++j) am = fmaxf(am, fmaxf(fmaxf(fabsf(v[q][j].x), fabsf(v[q][j].y)), fmaxf(fabsf(v[q][j].z), fabsf(v[q][j].w))));
#pragma unroll
                for (int o = 1; o < 64; o <<= 1) am = fmaxf(am, __shfl_xor(am, o));
                const float sc = am > 0.f ? am * (1.0f / 127.0f) : 1.0f, inv = 1.0f / sc;
                u32x4 o4;
#pragma unroll
                for (int j = 0; j < 4; ++j) {
                    const int q0 = (int)rintf(v[q][j].x * inv) + 128, q1 = (int)rintf(v[q][j].y * inv) + 128, q2 = (int)rintf(v[q][j].z * inv) + 128, q3 = (int)rintf(v[q][j].w * inv) + 128;
                    const unsigned w = (unsigned)(q0 < 0 ? 0 : (q0 > 255 ? 255 : q0)) | ((unsigned)(q1 < 0 ? 0 : (q1 > 255 ? 255 : q1)) << 8) |
                                       ((unsigned)(q2 < 0 ? 0 : (q2 > 255 ? 255 : q2)) << 16) | ((unsigned)(q3 < 0 ? 0 : (q3 > 255 ? 255 : q3)) << 24);
                    if (j == 0) o4.x = w; else if (j == 1) o4.y = w; else if (j == 2) o4.z = w; else o4.w = w;
                }
                unsigned char* dst = P.ws + (tb ? OFF_V : OFF_U);
                *(u32x4*)(dst + (size_t)e * DM + 16 * lane) = o4;
                if (lane == 0) ((float*)(P.ws + (tb ? OFF_VS : OFF_US)))[e] = sc;
            }
        }
    }
    constexpr int U_MOD = 12, U_MISC = 1, U_PB = 8;
    constexpr int U_WIN = 16 * 45, U_WOUT = 16 * 16, U_WQ = 16 * 32, U_W1 = 2 * 32 * 4, U_W2 = 2 * 4 * 1;
    constexpr int U_TOT = U_MOD + U_MISC + U_PB + U_WIN + U_WOUT + U_WQ + U_W1 + U_W2;
    for (int u = bid; u < U_TOT; u += G) {
        int r = u;
        constexpr bool EARLY = PART != 1, LATE = PART != 0;
        if (r < U_MOD) { if (EARLY) mod_unit(smem, P, r); continue; } r -= U_MOD;
        if (r < U_MISC) { if (EARLY) misc_unit(P); continue; } r -= U_MISC;
        if (r < U_PB) { if (EARLY) pb_unit(smem, P, r); continue; } r -= U_PB;
        if (r < U_WIN) { if (EARLY) transpose_unit(smem, P.w_in, 1024, 2840, (bf16_t*)(P.ws + OFF_WINT), r / 45, r % 45, 1); continue; } r -= U_WIN;
        if (r < U_WOUT) { if (LATE) transpose_unit(smem, P.w_out, 1024, 1024, (bf16_t*)(P.ws + OFF_WOUTT), r / 16, r % 16, 0); continue; } r -= U_WOUT;
        if (r < U_WQ) { if (LATE) transpose_unit(smem, P.peer_wq, 1024, 2048, (bf16_t*)(P.ws + OFF_WQT), r / 32, r % 32, 0); continue; } r -= U_WQ;
        if (r < U_W1) { if (EARLY) { const int kv = r / 128, q = r % 128; transpose_unit(smem, P.cmp_w1 + (size_t)kv * 2048 * 256, 2048, 256, (bf16_t*)(P.ws + OFF_W1T) + (size_t)kv * 256 * 2048, q / 4, q % 4, 0); } continue; } r -= U_W1;
        if (EARLY) { const int kv = r / 4, q = r % 4; transpose_unit(smem, P.cmp_w2 + (size_t)kv * 256 * 64, 256, 64, (bf16_t*)(P.ws + OFF_W2T) + (size_t)kv * 128 * 256, q, 0, 0); }
    }
}

template <bool BF16IN>
DI void phase_normmod(const Params& P, const void* __restrict__ xin_, const float* __restrict__ gvec, int sh_idx, int sc_idx, bf16_t* __restrict__ outp,
                      int row0 = 0, int row1 = NTOK, int bi = blockIdx.x, int nb = gridDim.x) {
    const int tid = ltid(), lane = tid & 63, wid = tid >> 6;
    const float* mod = (const float*)(P.ws + OFF_MOD);
    const int gw = bi * 8 + wid, NGW = nb * 8;
    for (int row = row0 + gw; row < row1; row += NGW) {
        const int b = row >> 12;
        f32x4 v[4]; float ss = 0.f;
        if (BF16IN) {
            const u32x2* xr = (const u32x2*)((const bf16_t*)xin_ + (size_t)row * DM) + lane;
#pragma unroll
            for (int j = 0; j < 4; ++j) { const u32x2 w = xr[64 * j]; v[j] = (f32x4){bf_lo(w.x), bf_hi(w.x), bf_lo(w.y), bf_hi(w.y)}; }
        } else {
            const f32x4* xr = (const f32x4*)((const float*)xin_ + (size_t)row * DM) + lane;
#pragma unroll
            for (int j = 0; j < 4; ++j) v[j] = xr[64 * j];
        }
#pragma unroll
        for (int j = 0; j < 4; ++j) ss += (v[j].x * v[j].x + v[j].y * v[j].y) + (v[j].z * v[j].z + v[j].w * v[j].w);
        const float rstd = __builtin_amdgcn_rsqf(wave_sum(ss) * (1.0f / DM) + RMS_EPS);
        const float* shp = mod + (size_t)b * 6144 + sh_idx * 1024;
        const float* scp = mod + (size_t)b * 6144 + sc_idx * 1024;
        u32x2* o8 = (u32x2*)(outp + (size_t)row * DM) + lane;
#pragma unroll
        for (int j = 0; j < 4; ++j) {
            const int col = 4 * lane + 256 * j;
            const f32x4 g = *(const f32x4*)(gvec + col), sc = *(const f32x4*)(scp + col), sh = *(const f32x4*)(shp + col);
            const float a0 = v[j].x * rstd * g.x * (1.f + sc.x) + sh.x, a1 = v[j].y * rstd * g.y * (1.f + sc.y) + sh.y;
            const float a2 = v[j].z * rstd * g.z * (1.f + sc.z) + sh.z, a3 = v[j].w * rstd * g.w * (1.f + sc.w) + sh.w;
            u32x2 w; w.x = pk2(a0, a1); w.y = pk2(a2, a3);
            o8[64 * j] = w;
        }
    }
}

constexpr int G_STAGE = 49152;
struct ARowMajor {
    const bf16_t* A; int lda;
    DI const bf16_t* operator()(int m, int kt) const { return A + (size_t)m * lda + kt * 64; }
};
struct ACmp {
    const bf16_t* src;
    DI const bf16_t* operator()(int m, int kt) const {
        const int bg = m >> 8; int c = m & 255; c = c > 254 ? 254 : c;
        return src + ((size_t)((bg >> 1) * SEQ + 16 * c + kt)) * 128 + (bg & 1) * 64;
    }
};

template <bool TRANS, class AF, class Epi>
DI void gemm_tile(char* smem, const AF& af, const bf16_t* __restrict__ Bt, int ldb, int m0, int n0, int nk, const Epi& epi) {
    const int tid = ltid(), lane = tid & 63, wid = tid >> 6, wr = wid >> 1, wc = wid & 1, fr = lane & 15, fq = lane >> 4;
    const int lrow = tid >> 3, lc = tid & 7;
    const int ldsoff = lrow * 128 + ((lc ^ ((tid >> 4) & 7)) << 4);
    const bf16_t* ap[4]; const bf16_t* bp[2];
#pragma unroll
    for (int i = 0; i < 4; ++i) ap[i] = af(m0 + lrow + 64 * i, 0) + lc * 8;
#pragma unroll
    for (int i = 0; i < 2; ++i) bp[i] = Bt + (size_t)(n0 + lrow + 64 * i) * ldb + lc * 8;
    const int astep = (int)(af(m0, 1) - af(m0, 0));
    f32x4 acc[4][4];
#pragma unroll
    for (int i = 0; i < 4; ++i)
#pragma unroll
        for (int j = 0; j < 4; ++j) acc[i][j] = (f32x4){0.f, 0.f, 0.f, 0.f};
    u32x4 ra[4], rb[2];
#pragma unroll
    for (int i = 0; i < 4; ++i) ra[i] = *(const u32x4*)(ap[i]);
#pragma unroll
    for (int i = 0; i < 2; ++i) rb[i] = *(const u32x4*)(bp[i]);
    __syncthreads();
#pragma unroll
    for (int i = 0; i < 4; ++i) *(u32x4*)(smem + ldsoff + i * 8192) = ra[i];
#pragma unroll
    for (int i = 0; i < 2; ++i) *(u32x4*)(smem + 32768 + ldsoff + i * 8192) = rb[i];
    __syncthreads();
    const int sws = fr >> 1;
    const int aoff = (64 * wr + fr) * 128, boff = 32768 + (64 * wc + fr) * 128;
    for (int kt = 0; kt < nk; ++kt) {
        const int st = kt & 1;
        if (kt + 1 < nk) {
#pragma unroll
            for (int i = 0; i < 4; ++i) ra[i] = *(const u32x4*)(ap[i] + (size_t)(kt + 1) * astep);
#pragma unroll
            for (int i = 0; i < 2; ++i) rb[i] = *(const u32x4*)(bp[i] + (kt + 1) * 64);
        }
        const char* sb = smem + st * G_STAGE;
#pragma unroll
        for (int kk = 0; kk < 2; ++kk) {
            const int cho = ((kk * 4 + fq) ^ sws) << 4;
            bf16x8 afr[4], bfr[4];
#pragma unroll
            for (int i = 0; i < 4; ++i) afr[i] = *(const bf16x8*)(sb + aoff + i * 2048 + cho);
#pragma unroll
            for (int j = 0; j < 4; ++j) bfr[j] = *(const bf16x8*)(sb + boff + j * 2048 + cho);
#pragma unroll
            for (int i = 0; i < 4; ++i)
#pragma unroll
                for (int j = 0; j < 4; ++j)
                    acc[i][j] = TRANS ? MFMA16(afr[i], bfr[j], acc[i][j]) : MFMA16(bfr[j], afr[i], acc[i][j]);
        }
        if (kt + 1 < nk) {
            char* sn = smem + (st ^ 1) * G_STAGE;
#pragma unroll
            for (int i = 0; i < 4; ++i) *(u32x4*)(sn + ldsoff + i * 8192) = ra[i];
#pragma unroll
            for (int i = 0; i < 2; ++i) *(u32x4*)(sn + 32768 + ldsoff + i * 8192) = rb[i];
        }
        __syncthreads();
    }
#pragma unroll
    for (int i = 0; i < 4; ++i)
#pragma unroll
        for (int j = 0; j < 4; ++j) {
            if (TRANS) epi.tr(m0 + 64 * wr + 16 * i + 4 * fq, n0 + 64 * wc + 16 * j + fr, acc[i][j]);
            else epi.nt(m0 + 64 * wr + 16 * i + fr, n0 + 64 * wc + 16 * j + 4 * fq, acc[i][j]);
        }
}

DI void st_bf8(bf16_t* p, f32x4 a, f32x4 b, float s) { u32x4 w; w.x = pk2(a.x * s, a.y * s); w.y = pk2(a.z * s, a.w * s); w.z = pk2(b.x * s, b.y * s); w.w = pk2(b.z * s, b.w * s); *(u32x4*)p = w; }
DI void st_bf4(bf16_t* p, f32x4 v, float s) { u32x2 w; w.x = pk2(v.x * s, v.y * s); w.y = pk2(v.z * s, v.w * s); *(u32x2*)p = w; }

struct EpiInProj {
    unsigned char* ws;
    DI void nt8(int m, int n, f32x4 v0, f32x4 v1) const {
        if (n < 512) st_bf8((bf16_t*)(ws + OFF_QN) + (size_t)m * 512 + n, v0, v1, QSCALE);
        else if (n < 640) st_bf8((bf16_t*)(ws + OFF_KC) + (size_t)m * 128 + (n - 512), v0, v1, 1.f);
        else if (n < 768) st_bf8((bf16_t*)(ws + OFF_VC) + (size_t)m * 128 + (n - 640), v0, v1, 1.f);
        else if (n < 896) st_bf8((bf16_t*)(ws + OFF_KS) + (size_t)m * 128 + (n - 768), v0, v1, 1.f);
        else if (n < 1024) st_bf8((bf16_t*)(ws + OFF_KW) + (size_t)m * 128 + (n - 896), v0, v1, 1.f);
        else if (n < 1536) st_bf8((bf16_t*)(ws + OFF_DQ) + (size_t)m * 512 + (n - 1024), v0, v1, QSCALE);
        else if (n < 2048) st_bf8((bf16_t*)(ws + OFF_DK) + (size_t)m * 512 + (n - 1536), v0, v1, 1.f);
        else if (n < 2072) {
            float* gp = (float*)(ws + OFF_GATES) + (size_t)m * 24 + (n - 2048);
            f32x4 o0, o1;
            o0.x = 1.f / (1.f + __expf(-v0.x)); o0.y = 1.f / (1.f + __expf(-v0.y)); o0.z = 1.f / (1.f + __expf(-v0.z)); o0.w = 1.f / (1.f + __expf(-v0.w));
            o1.x = 1.f / (1.f + __expf(-v1.x)); o1.y = 1.f / (1.f + __expf(-v1.y)); o1.z = 1.f / (1.f + __expf(-v1.z)); o1.w = 1.f / (1.f + __expf(-v1.w));
            *(f32x4*)gp = o0; *(f32x4*)(gp + 4) = o1;
        }
    }
};
struct EpiInProjT {
    unsigned char* ws;
    DI void nt8(int vr, int t, f32x4 v0, f32x4 v1) const {
        const int b = t >> 12, sq = t & 4095;
        bf16_t* dst;
        if (vr < 128) dst = (bf16_t*)(ws + OFF_VST) + ((size_t)(b * 128 + vr)) * SEQ + sq;
        else if (vr < 256) dst = (bf16_t*)(ws + OFF_VWT) + ((size_t)(b * 128 + (vr - 128))) * SEQ + sq;
        else dst = (bf16_t*)(ws + OFF_DVT) + ((size_t)(b * 512 + (vr - 256))) * SEQ + sq;
        st_bf8(dst, v0, v1, 1.f);
    }
};
DI bool inproj_tile_is_trans(int) { return false; }

struct EpiCmp1 {
    bf16_t* hid; const float* pb;
    DI void nt(int m, int n, f32x4 v) const {
        const f32x4 p = *(const f32x4*)(pb + n);
        u32x2 w; w.x = pk2(gelu_tanh(v.x + p.x), gelu_tanh(v.y + p.y)); w.y = pk2(gelu_tanh(v.z + p.z), gelu_tanh(v.w + p.w));
        *(u32x2*)(hid + (size_t)m * 256 + n) = w;
    }
    DI void tr(int, int, f32x4) const {}
};
struct EpiCmp2 {
    bf16_t* kc; bf16_t* vt;
    DI void nt(int m, int n, f32x4 v) const { if (n < 64) st_bf4(kc + (size_t)m * 64 + n, v, 1.f); }
    DI void tr(int m, int n, f32x4 v) const { if (n < 64) st_bf4(vt + ((size_t)((m >> 8) * 64 + n)) * 256 + (m & 255), v, 1.f); }
};
struct EpiOutProj {
    const float* x; const float* mod; bf16_t* x1;
    DI void nt(int m, int n, f32x4 v) const {
        const int b = m >> 12;
        const f32x4 g = *(const f32x4*)(mod + (size_t)b * 6144 + 2 * 1024 + n);
        const f32x4 xv = *(const f32x4*)(x + (size_t)m * DM + n);
        f32x4 o; o.x = xv.x + g.x * v.x; o.y = xv.y + g.y * v.y; o.z = xv.z + g.z * v.z; o.w = xv.w + g.w * v.w;
        st_bf4(x1 + (size_t)m * DM + n, o, 1.f);
    }
    DI void nt8(int m, int n, f32x4 v0, f32x4 v1) const {
        const int b = m >> 12;
        const float* gp = mod + (size_t)b * 6144 + 2 * 1024 + n; const float* xp = x + (size_t)m * DM + n;
        const f32x4 g0 = *(const f32x4*)gp, g1 = *(const f32x4*)(gp + 4), x0 = *(const f32x4*)xp, xq = *(const f32x4*)(xp + 4);
        f32x4 o0, o1;
        o0.x = x0.x + g0.x * v0.x; o0.y = x0.y + g0.y * v0.y; o0.z = x0.z + g0.z * v0.z; o0.w = x0.w + g0.w * v0.w;
        o1.x = xq.x + g1.x * v1.x; o1.y = xq.y + g1.y * v1.y; o1.z = xq.z + g1.z * v1.z; o1.w = xq.w + g1.w * v1.w;
        st_bf8(x1 + (size_t)m * DM + n, o0, o1, 1.f);
    }
    DI void tr(int, int, f32x4) const {}
};
struct EpiWq {
    bf16_t* qp;
    DI void nt8(int m, int n, f32x4 v0, f32x4 v1) const {
        const int d = n & 127;
        bf16_t* dst = qp + ((size_t)(m >> 5) * 16 + (n >> 7)) * 4096 + (size_t)((d >> 3) * 32 + (m & 31)) * 8;
        st_bf8(dst, v0, v1, 1.f);
    }
    DI void nt(int, int, f32x4) const {}
    DI void tr(int, int, f32x4) const {}
};

namespace pg8 {
#define PG8_LAS __attribute__((address_space(3)))
typedef unsigned short bf16_t;
typedef short bf16x8 __attribute__((ext_vector_type(8)));
typedef float f32x4 __attribute__((ext_vector_type(4)));
typedef unsigned u32x4 __attribute__((ext_vector_type(4)));
constexpr int BM = 256, BK = 64, HALF = 128, HTB = HALF * BK * 2  , STAGE_BYTES = 8 * HTB, NXCD = 8, WGM = 8;

__host__ __device__ __forceinline__ int lds_byte(int r, int c) { const int st = (r >> 4) * 2 + (c >> 5), rr = r & 15, cc = c & 31, ob = rr * 64 + cc * 2; return st * 1024 + (ob ^ (((ob >> 9) & 1) << 5)); }
__host__ __device__ __forceinline__ void stage_rc(int b, int& R, int& C) { const int st = b / 1024, sb = b % 1024, swz = sb ^ (((sb >> 9) & 1) << 5); R = (st >> 1) * 16 + swz / 64; C = (st & 1) * 32 + (swz % 64) / 2; }
__host__ __device__ __forceinline__ int perm32(int rho) { const int n = rho >> 4, i = rho & 15; return 8 * (i >> 2) + 4 * n + (i & 3); }

struct Unit { int pm, pn; };
struct Gemm { const bf16_t* A; const bf16_t* Bt; int M, N, K; };

struct StaticOrder {
    int nM, nN, nwg, G, c;
    __host__ __device__ void init(int M, int N, int G_, int c_) { nM = M / BM; nN = N / BM; nwg = nM * nN; G = G_; c = c_; }
    __host__ __device__ bool next(int i, Unit& u) const {
        const long L = (long)i * G + c; if (L >= nwg) return false;
        int wgid = (int)L; { const int q = nwg / NXCD, r = nwg % NXCD, xcd = wgid % NXCD, off = wgid / NXCD; wgid = (xcd < r ? xcd * (q + 1) : r * (q + 1) + (xcd - r) * q) + off; }
        const int nig = WGM * nN, gid = wgid / nig, fm = gid * WGM, gsz = (nM - fm) < WGM ? (nM - fm) : WGM;
        u.pm = fm + ((wgid % nig) % gsz); u.pn = (wgid % nig) / gsz; return true;
    }
    __device__ __forceinline__ void a_ready(const Unit&) const {}
    __device__ __forceinline__ void done(const Unit&) const {}
};


template <class Epi, class Sched, bool ALIGN_EPI = false, bool SP2 = false>
__device__ __forceinline__ void gemm_phase(PG8_LAS unsigned char* lds, const Gemm g, const Sched& S, const Epi& E) {
    const int tid = ltid(), wid = __builtin_amdgcn_readfirstlane(tid >> 6), lane = tid & 63, wr = wid >> 2, wc = wid & 3, fr = lane & 15, fq = lane >> 4;
    const int K = g.K, nt = K / BK;
    unsigned voffA[2], voffB[2];
#pragma unroll
    for (int i = 0; i < 2; ++i) { int R, C; stage_rc(tid * 16 + i * 8192, R, C); const int Rb = Epi::PERM ? ((R & ~31) + perm32(R & 31)) : R;
        voffA[i] = (unsigned)(R * K + C) * 2u; voffB[i] = (unsigned)(Rb * K + C) * 2u; }
    const size_t kstep = (size_t)(BK * 2);
    const size_t hstep = (size_t)HALF * K * 2;
    const size_t tstep = 2 * hstep;
    const unsigned ldsw = (unsigned)wid * 1024u;
    const int aoff = lds_byte(wr * 64 + fr, fq * 8), boff = lds_byte(wc * 32 + fr, fq * 8);
#define PG8_SA(b, h) (((b) * 2 + (h)) * HTB)
#define PG8_SB(b, h) ((4 + (b) * 2 + (h)) * HTB)
#define PG8_STAGE(bufoff, gbase, voff) do { _Pragma("unroll") for (int _i = 0; _i < 2; ++_i) \
        __builtin_amdgcn_global_load_lds((const unsigned*)((const char*)(gbase) + (voff)[_i]), (PG8_LAS unsigned*)(lds + (bufoff) + ldsw + _i * 8192), 16, 0, 0); } while (0)
#define PG8_LDA(dst, b, h) do { _Pragma("unroll") for (int m = 0; m < 4; ++m) _Pragma("unroll") for (int k = 0; k < 2; ++k) dst[m][k] = *(const PG8_LAS bf16x8*)(lds + PG8_SA(b, h) + aoff + m * 2048 + k * 1024); } while (0)
#define PG8_LDB(dst, b, h) do { _Pragma("unroll") for (int n = 0; n < 2; ++n) _Pragma("unroll") for (int k = 0; k < 2; ++k) dst[n][k] = *(const PG8_LAS bf16x8*)(lds + PG8_SB(b, h) + boff + n * 2048 + k * 1024); } while (0)
#define PG8_MMA(ai, bj, At, Bt) do { __builtin_amdgcn_s_setprio(1); _Pragma("unroll") for (int m = 0; m < 4; ++m) _Pragma("unroll") for (int n = 0; n < 2; ++n) _Pragma("unroll") for (int k = 0; k < 2; ++k) \
        acc[ai][bj][m][n] = __builtin_amdgcn_mfma_f32_16x16x32_bf16(Bt[n][k], At[m][k], acc[ai][bj][m][n], 0, 0, 0); __builtin_amdgcn_s_setprio(0); } while (0)
#define PG8_WAIT_V(n) asm volatile("s_waitcnt vmcnt(" #n ")" ::: "memory")
#define PG8_WAIT_L(n) asm volatile("s_waitcnt lgkmcnt(" #n ")" ::: "memory")
#define PG8_BAR __builtin_amdgcn_s_barrier()
#define PG8_SCHED __builtin_amdgcn_sched_barrier(0)
    Unit cur, nxt; int ui = 0;
    if (!S.next(0, cur)) return;
    f32x4 acc[2][2][4][2];
#pragma unroll
    for (int a = 0; a < 2; ++a)
#pragma unroll
        for (int b = 0; b < 2; ++b)
#pragma unroll
            for (int m = 0; m < 4; ++m)
#pragma unroll
                for (int n = 0; n < 2; ++n) acc[a][b][m][n] = (f32x4){0.f, 0.f, 0.f, 0.f};
    bf16x8 At[4][2], B0[2][2], B1[2][2];
    const char* cA = (const char*)g.A + (size_t)cur.pm * tstep; const char* cB = (const char*)g.Bt + (size_t)cur.pn * tstep;
    S.a_ready(cur);
    if constexpr (SP2) {
        PG8_STAGE(PG8_SB(0, 0), cB, voffB); PG8_STAGE(PG8_SB(0, 1), cB + hstep, voffB); PG8_STAGE(PG8_SA(0, 0), cA, voffA); PG8_STAGE(PG8_SA(0, 1), cA + hstep, voffA);
        if (wr == 1) PG8_BAR;
        PG8_WAIT_V(2); PG8_BAR;
        PG8_STAGE(PG8_SB(1, 0), cB + kstep, voffB); PG8_STAGE(PG8_SA(1, 0), cA + kstep, voffA); PG8_STAGE(PG8_SB(1, 1), cB + hstep + kstep, voffB);
        PG8_WAIT_V(6); PG8_BAR;
    } else {
        PG8_STAGE(PG8_SB(0, 0), cB, voffB); PG8_STAGE(PG8_SA(0, 0), cA, voffA); PG8_STAGE(PG8_SB(0, 1), cB + hstep, voffB); PG8_STAGE(PG8_SA(0, 1), cA + hstep, voffA);
        if (wr == 1) PG8_BAR;
        PG8_WAIT_V(4); PG8_BAR;
        PG8_STAGE(PG8_SB(1, 0), cB + kstep, voffB); PG8_STAGE(PG8_SA(1, 0), cA + kstep, voffA); PG8_STAGE(PG8_SB(1, 1), cB + hstep + kstep, voffB);
        PG8_WAIT_V(6); PG8_BAR;
    }
    for (;;) {
        const bool has_next = S.next(ui + 1, nxt);
        const char* nA = has_next ? (const char*)g.A + (size_t)nxt.pm * tstep : cA; const char* nB = has_next ? (const char*)g.Bt + (size_t)nxt.pn * tstep : cB;
        for (int t = 0; t < nt; t += 2) {
            const bool last = (t == nt - 2);
            const char* a1 = cA + (size_t)(t + 1) * kstep;
            const char* a2 = last ? nA : cA + (size_t)(t + 2) * kstep; const char* b2 = last ? nB : cB + (size_t)(t + 2) * kstep;
            const char* a3 = a2 + kstep; const char* b3 = b2 + kstep;
            if (last && has_next) S.a_ready(nxt);
            if constexpr (SP2) {
            PG8_LDB(B0, 0, 0); PG8_LDB(B1, 0, 1); PG8_SCHED; PG8_LDA(At, 0, 0); PG8_STAGE(PG8_SA(1, 1), a1 + hstep, voffA);
            PG8_WAIT_V(8); PG8_WAIT_L(0); PG8_BAR; PG8_MMA(0, 0, At, B0); PG8_MMA(0, 1, At, B1); PG8_BAR; PG8_SCHED;
            PG8_LDA(At, 0, 1); PG8_STAGE(PG8_SB(0, 0), b2, voffB); PG8_STAGE(PG8_SB(0, 1), b2 + hstep, voffB); PG8_STAGE(PG8_SA(0, 0), a2, voffA);
            PG8_WAIT_V(8); PG8_WAIT_L(0); PG8_BAR; PG8_MMA(1, 0, At, B0); PG8_MMA(1, 1, At, B1); PG8_BAR; PG8_SCHED;
            PG8_LDB(B0, 1, 0); PG8_LDB(B1, 1, 1); PG8_SCHED; PG8_LDA(At, 1, 0); PG8_STAGE(PG8_SA(0, 1), a2 + hstep, voffA);
            PG8_WAIT_V(8); PG8_WAIT_L(0); PG8_BAR; PG8_MMA(0, 0, At, B0); PG8_MMA(0, 1, At, B1); PG8_BAR; PG8_SCHED;
            PG8_LDA(At, 1, 1); PG8_STAGE(PG8_SB(1, 0), b3, voffB); PG8_STAGE(PG8_SB(1, 1), b3 + hstep, voffB); PG8_STAGE(PG8_SA(1, 0), a3, voffA);
            PG8_WAIT_V(8); PG8_WAIT_L(0); PG8_BAR; PG8_MMA(1, 0, At, B0); PG8_MMA(1, 1, At, B1); PG8_BAR; PG8_SCHED;
            } else {
            PG8_LDB(B0, 0, 0); PG8_SCHED; PG8_LDA(At, 0, 0); PG8_STAGE(PG8_SA(1, 1), a1 + hstep, voffA);
            PG8_WAIT_L(8); PG8_BAR; PG8_WAIT_L(0); PG8_MMA(0, 0, At, B0); PG8_BAR; PG8_SCHED;
            PG8_LDB(B1, 0, 1); PG8_STAGE(PG8_SB(0, 0), b2, voffB);
            PG8_BAR; PG8_WAIT_L(0); PG8_MMA(0, 1, At, B1); PG8_BAR;
            PG8_LDA(At, 0, 1); PG8_STAGE(PG8_SA(0, 0), a2, voffA);
            PG8_BAR; PG8_WAIT_L(0); PG8_MMA(1, 0, At, B0); PG8_BAR; PG8_SCHED;
            PG8_STAGE(PG8_SB(0, 1), b2 + hstep, voffB);
            PG8_WAIT_V(6); PG8_BAR; PG8_MMA(1, 1, At, B1); PG8_BAR;
            PG8_LDB(B0, 1, 0); PG8_SCHED; PG8_LDA(At, 1, 0); PG8_STAGE(PG8_SA(0, 1), a2 + hstep, voffA);
            PG8_WAIT_L(8); PG8_BAR; PG8_WAIT_L(0); PG8_MMA(0, 0, At, B0); PG8_BAR; PG8_SCHED;
            PG8_LDB(B1, 1, 1); PG8_STAGE(PG8_SB(1, 0), b3, voffB);
            PG8_BAR; PG8_WAIT_L(0); PG8_MMA(0, 1, At, B1); PG8_BAR;
            PG8_LDA(At, 1, 1); PG8_STAGE(PG8_SA(1, 0), a3, voffA);
            PG8_BAR; PG8_WAIT_L(0); PG8_MMA(1, 0, At, B0); PG8_BAR; PG8_SCHED;
            PG8_STAGE(PG8_SB(1, 1), b3 + hstep, voffB);
            PG8_WAIT_V(6); PG8_BAR; PG8_MMA(1, 1, At, B1); PG8_BAR;
            }
        }
        if constexpr (ALIGN_EPI) { if (wr == 0) PG8_BAR; }
        if constexpr (!Epi::AFTER_DRAIN) { E(acc, cur, wr, wc, fr, fq); S.done(cur); }
        if (!has_next) break;
#pragma unroll
        for (int a = 0; a < 2; ++a)
#pragma unroll
            for (int b = 0; b < 2; ++b)
#pragma unroll
                for (int m = 0; m < 4; ++m)
#pragma unroll
                    for (int n = 0; n < 2; ++n) acc[a][b][m][n] = (f32x4){0.f, 0.f, 0.f, 0.f};
        cur = nxt; cA = nA; cB = nB; ++ui;
        if constexpr (ALIGN_EPI) { if (wr == 1) PG8_BAR; }
    }
    PG8_WAIT_V(0);
    if constexpr (!ALIGN_EPI) { if (wr == 0) PG8_BAR; }
    PG8_BAR;
    if constexpr (Epi::AFTER_DRAIN) { E.fused(acc, cur, wr, wc, fr, fq, lds, wid, lane); S.done(cur); }
#undef PG8_SA
#undef PG8_SB
#undef PG8_STAGE
#undef PG8_LDA
#undef PG8_LDB
#undef PG8_MMA
#undef PG8_WAIT_V
#undef PG8_WAIT_L
#undef PG8_BAR
#undef PG8_SCHED
}
}


template <class F> struct EpiPg8 {
    static constexpr bool PERM = true, AFTER_DRAIN = false;
    F f;
    DI void operator()(const pg8::f32x4 (&acc)[2][2][4][2], const pg8::Unit& u, int wr, int wc, int fr, int fq) const {
#pragma unroll
        for (int ai = 0; ai < 2; ++ai)
#pragma unroll
            for (int m = 0; m < 4; ++m) {
                const int row = u.pm * 256 + 128 * ai + 64 * wr + 16 * m + fr;
#pragma unroll
                for (int bj = 0; bj < 2; ++bj) f.nt8(row, u.pn * 256 + 128 * bj + 32 * wc + 8 * fq, acc[ai][bj][m][0], acc[ai][bj][m][1]);
            }
    }
};

constexpr int VT_PITCH = 128;
DI int kperm(int rho) { return (rho & ~12) | ((rho & 4) << 1) | ((rho & 8) >> 1); }
DI int kidx(int reg, int h) { return (reg & 3) + 4 * ((reg >> 2) & 1) + 8 * h + 16 * (reg >> 3); }
#define LAS3 __attribute__((address_space(3)))
DI void glds16(const void* gsrc, char* lds_wave_base) { __builtin_amdgcn_global_load_lds((const unsigned*)gsrc, (LAS3 unsigned*)lds_wave_base, 16, 0, 0); }
constexpr float RESCALE_THR = 8.0f;

DI unsigned lds_addr(const char* p) { return (unsigned)(size_t)(LAS3 const char*)p; }
template <int OFF> DI bf16x8 ds128(unsigned a) { bf16x8 v; asm volatile("ds_read_b128 %0, %1 offset:%2" : "=v"(v) : "v"(a), "n"(OFF)); return v; }
#define MFMA_FENCE __builtin_amdgcn_sched_barrier(0)
#define LGKM_WAIT1(n, a) asm volatile("s_waitcnt lgkmcnt(" #n ")" : "+v"(a))
#define LGKM_WAIT2(n, a, b) asm volatile("s_waitcnt lgkmcnt(" #n ")" : "+v"(a), "+v"(b))
DI void qk_tile(const char* Ks, const bf16x8 (&qf)[4], int r, int h, const f32x16& cinit, f32x16& s0, f32x16& s1) {
    const int sw = (r >> 1) & 7;
    const unsigned kb = lds_addr(Ks) + r * 128;
    bf16x8 k0[4], k1[4];
#pragma unroll
    for (int ks = 0; ks < 4; ++ks) {
        const unsigned ka = kb + (((2 * ks + h) ^ sw) << 4);
        k0[ks] = ds128<0>(ka);
        k1[ks] = ds128<4096>(ka);
    }
    LGKM_WAIT2(6, k0[0], k1[0]);
    s0 = MFMA32(k0[0], qf[0], cinit); s1 = MFMA32(k1[0], qf[0], cinit);
    MFMA_FENCE;
    LGKM_WAIT2(4, k0[1], k1[1]);
    s0 = MFMA32(k0[1], qf[1], s0); s1 = MFMA32(k1[1], qf[1], s1);
    MFMA_FENCE;
    LGKM_WAIT2(2, k0[2], k1[2]);
    s0 = MFMA32(k0[2], qf[2], s0); s1 = MFMA32(k1[2], qf[2], s1);
    MFMA_FENCE;
    LGKM_WAIT2(0, k0[3], k1[3]);
    s0 = MFMA32(k0[3], qf[3], s0); s1 = MFMA32(k1[3], qf[3], s1);
    asm volatile("s_nop 15\n\ts_nop 7" : "+v"(s0), "+v"(s1));
}
DI void v_prefetch(const char* Vs, int r, int h, bf16x8 (&vf0)[4]) {
    const int sw = (r >> 1) & 7;
    const unsigned vb = lds_addr(Vs) + r * VT_PITCH;
#pragma unroll
    for (int st = 0; st < 4; ++st) vf0[st] = ds128<0>(vb + (((2 * st + h) ^ sw) << 4));
}
template <int NDT, int DT>
DI void pv_steps(const unsigned (&va)[4], bf16x8 (&cur)[4], const bf16x8 (&pf)[4], f32x16 (&o)[NDT]) {
    bf16x8 nxt[4];
    if constexpr (DT + 1 < NDT) {
#pragma unroll
        for (int st = 0; st < 4; ++st) nxt[st] = ds128<32 * VT_PITCH * (DT + 1)>(va[st]);
        LGKM_WAIT1(7, cur[0]); o[DT] = MFMA32(cur[0], pf[0], o[DT]);
        LGKM_WAIT1(6, cur[1]); o[DT] = MFMA32(cur[1], pf[1], o[DT]);
        LGKM_WAIT1(5, cur[2]); o[DT] = MFMA32(cur[2], pf[2], o[DT]);
        LGKM_WAIT1(4, cur[3]); o[DT] = MFMA32(cur[3], pf[3], o[DT]);
        MFMA_FENCE;
        pv_steps<NDT, DT + 1>(va, nxt, pf, o);
    } else {
        LGKM_WAIT1(3, cur[0]); o[DT] = MFMA32(cur[0], pf[0], o[DT]);
        LGKM_WAIT1(2, cur[1]); o[DT] = MFMA32(cur[1], pf[1], o[DT]);
        LGKM_WAIT1(1, cur[2]); o[DT] = MFMA32(cur[2], pf[2], o[DT]);
        LGKM_WAIT1(0, cur[3]); o[DT] = MFMA32(cur[3], pf[3], o[DT]);
    }
}
template <int NDT>
DI void pv_tile(const char* Vs, bf16x8 (&vf0)[4], const bf16x8 (&pf)[4], int r, int h, f32x16 (&o)[NDT]) {
    const int sw = (r >> 1) & 7;
    const unsigned vb = lds_addr(Vs) + r * VT_PITCH;
    unsigned va[4];
#pragma unroll
    for (int st = 0; st < 4; ++st) va[st] = vb + (((2 * st + h) ^ sw) << 4);
    pv_steps<NDT, 0>(va, vf0, pf, o);
}
DI void pack_p(const f32x16& p0, const f32x16& p1, bf16x8 (&pf)[4]) {
#pragma unroll
    for (int s = 0; s < 2; ++s) {
        u32x4 a, b;
        a.x = pk2(p0[8 * s + 0], p0[8 * s + 1]); a.y = pk2(p0[8 * s + 2], p0[8 * s + 3]); a.z = pk2(p0[8 * s + 4], p0[8 * s + 5]); a.w = pk2(p0[8 * s + 6], p0[8 * s + 7]);
        b.x = pk2(p1[8 * s + 0], p1[8 * s + 1]); b.y = pk2(p1[8 * s + 2], p1[8 * s + 3]); b.z = pk2(p1[8 * s + 4], p1[8 * s + 5]); b.w = pk2(p1[8 * s + 6], p1[8 * s + 7]);
        pf[s] = __builtin_bit_cast(bf16x8, a);
        pf[2 + s] = __builtin_bit_cast(bf16x8, b);
    }
}
template <int MODE>
DI void mask_tile(f32x16& s0, f32x16& s1, int h, int tq, int stride, int dmax, bool lane_ok, const float* tab) {
    if (MODE == 1) {
        if (!lane_ok) {
#pragma unroll
            for (int i = 0; i < 16; ++i) { s0[i] = NEGB; s1[i] = NEGB; }
        }
    } else if (MODE == 2) {
        const unsigned udm = (unsigned)dmax;
#pragma unroll
        for (int g4 = 0; g4 < 4; ++g4) {
            float bb[8]; int dd[8];
#pragma unroll
            for (int e = 0; e < 4; ++e) {
                const int k0 = kidx(4 * g4 + e, h);
                dd[2 * e] = tq - stride * k0; dd[2 * e + 1] = tq - stride * (k0 + 32);
            }
#pragma unroll
            for (int e = 0; e < 8; ++e) { const int ix = dd[e] < 0 ? 0 : (dd[e] > 127 ? 127 : dd[e]); bb[e] = tab[ix]; }
            asm volatile("" : "+v"(bb[0]), "+v"(bb[1]), "+v"(bb[2]), "+v"(bb[3]), "+v"(bb[4]), "+v"(bb[5]), "+v"(bb[6]), "+v"(bb[7]));
#pragma unroll
            for (int e = 0; e < 4; ++e) {
                const int i = 4 * g4 + e;
                const bool v0 = lane_ok && (unsigned)dd[2 * e] < udm, v1 = lane_ok && (unsigned)dd[2 * e + 1] < udm;
                s0[i] = v0 ? s0[i] + bb[2 * e] : NEGB;
                s1[i] = v1 ? s1[i] + bb[2 * e + 1] : NEGB;
            }
        }
    }
}
DI float max2(float a, float b) { return __builtin_amdgcn_fmed3f(a, b, __builtin_inff()); }
DI float max3f(float a, float b, float c) { float r; asm("v_max3_f32 %0, %1, %2, %3" : "=v"(r) : "v"(a), "v"(b), "v"(c)); return r; }
DI float max2f(float a, float b) { float r; asm("v_max_f32_e32 %0, %1, %2" : "=v"(r) : "v"(a), "v"(b)); return r; }
DI float tile_max(const f32x16& s0, const f32x16& s1) {
    float a = max3f(s0[0], s0[1], s1[0]), b = max3f(s0[2], s0[3], s1[1]);
    a = max3f(a, s1[2], s1[3]);
#pragma unroll
    for (int i = 4; i < 16; i += 4) { a = max3f(a, s0[i], s0[i + 1]); b = max3f(b, s0[i + 2], s0[i + 3]); a = max3f(a, s1[i], s1[i + 1]); b = max3f(b, s1[i + 2], s1[i + 3]); }
    return max2f(a, b);
}
typedef float f32x2 __attribute__((ext_vector_type(2)));
constexpr float M_INIT = -64.f;
DI float exp_sum(f32x16& s0, f32x16& s1) {
    f32x2 acc0 = {0.f, 0.f}, acc1 = {0.f, 0.f};
#pragma unroll
    for (int i = 0; i < 16; i += 2) {
        const float a0 = __builtin_amdgcn_exp2f(s0[i]), a1 = __builtin_amdgcn_exp2f(s0[i + 1]), b0 = __builtin_amdgcn_exp2f(s1[i]), b1 = __builtin_amdgcn_exp2f(s1[i + 1]);
        s0[i] = a0; s0[i + 1] = a1; s1[i] = b0; s1[i + 1] = b1;
        acc0 += (f32x2){a0, a1}; acc1 += (f32x2){b0, b1};
    }
    acc0 += acc1;
    return acc0.x + acc0.y;
}
template <int MODE, int NDT>
DI void softmax_step(f32x16& s0, f32x16& s1, f32x16& negm, float& l, f32x16 (&o)[NDT], bool lane_ok) {
    float mx = tile_max(s0, s1);
    if (MODE == 1) mx = lane_ok ? mx : NEGB;
    if (__any(mx > RESCALE_THR)) {
        mx = max2(mx, __shfl_xor(mx, 32));
        const float d = max2(mx, 0.f);
        const float alpha = __builtin_amdgcn_exp2f(-d);
        const float nm = negm[0] - d;
        l *= alpha;
#pragma unroll
        for (int dt = 0; dt < NDT; ++dt)
#pragma unroll
            for (int i = 0; i < 16; ++i) o[dt][i] *= alpha;
#pragma unroll
        for (int i = 0; i < 16; ++i) { s0[i] -= d; s1[i] -= d; negm[i] = nm; }
    }
    f32x2 acc0 = {0.f, 0.f}, acc1 = {0.f, 0.f};
#pragma unroll
    for (int i = 0; i < 16; i += 2) {
        const float a0 = __builtin_amdgcn_exp2f(s0[i]), a1 = __builtin_amdgcn_exp2f(s0[i + 1]), b0 = __builtin_amdgcn_exp2f(s1[i]), b1 = __builtin_amdgcn_exp2f(s1[i + 1]);
        s0[i] = a0; s0[i + 1] = a1; s1[i] = b0; s1[i + 1] = b1;
        acc0 += (f32x2){a0, a1}; acc1 += (f32x2){b0, b1};
    }
    acc0 += acc1;
    const float sum = acc0.x + acc0.y;
    l += (MODE == 1) ? (lane_ok ? sum : 0.f) : sum;
}
template <bool EDGE>
DI void build_vtab(float* T, const float* tab2g, int N, int D0, int i0, int step) {
    for (int idx = i0; idx < 4 * N; idx += step) {
        const int p = idx / N, k = idx - p * N, d = D0 - (k + p);
        float v;
        if (EDGE) v = d < 512 ? 0.f : NEGB;
        else v = d < 0 ? NEGB : (d < 128 ? tab2g[d] : 0.f);
        T[idx] = v;
    }
}
DI void mask_vec(f32x16& s0, f32x16& s1, int h, int tq, const float* T, int N, int D0) {
    const int x0 = D0 - tq + 8 * h, p = x0 & 3;
    const float* base = T + p * N + (x0 - p);
    f32x4 v[8];
#pragma unroll
    for (int kh = 0; kh < 2; ++kh)
#pragma unroll
        for (int g = 0; g < 4; ++g) v[4 * kh + g] = *(const f32x4*)(base + 4 * (g & 1) + 16 * (g >> 1) + 32 * kh);
#pragma unroll
    for (int g = 0; g < 4; ++g) {
        s0[4 * g] += v[g].x; s0[4 * g + 1] += v[g].y; s0[4 * g + 2] += v[g].z; s0[4 * g + 3] += v[g].w;
        s1[4 * g] += v[4 + g].x; s1[4 * g + 1] += v[4 + g].y; s1[4 * g + 2] += v[4 + g].z; s1[4 * g + 3] += v[4 + g].w;
    }
}
template <int MODE, int NDT>
DI void attn_tile(const char* Ks, const char* Vs, const bf16x8 (&qf)[4], int r_in, int h_in, f32x16& negm, float& l, f32x16 (&o)[NDT],
                  int tq, int stride, int dmax, bool lane_ok, const float* tab) {
    int lane_ = r_in + 32 * h_in;
    asm volatile("" : "+v"(lane_), "+v"(tq));
    const int r = lane_ & 31, h = lane_ >> 5;
    f32x16 s0, s1;
    qk_tile(Ks, qf, r, h, negm, s0, s1);
    bf16x8 vf0[4];
    v_prefetch(Vs, r, h, vf0);
    if (MODE == 2) mask_tile<2>(s0, s1, h, tq, stride, dmax, lane_ok, tab);
    if (MODE == 3) mask_vec(s0, s1, h, tq, tab, stride, dmax);
    softmax_step<(MODE == 1 || MODE == 3) ? 1 : 0, NDT>(s0, s1, negm, l, o, lane_ok);
    bf16x8 pf[4];
    pack_p(s0, s1, pf);
    if (MODE == 1 || MODE == 3) {
#pragma unroll
        for (int i = 0; i < 4; ++i) {
            u32x4 v = __builtin_bit_cast(u32x4, pf[i]);
            v.x = lane_ok ? v.x : 0u; v.y = lane_ok ? v.y : 0u; v.z = lane_ok ? v.z : 0u; v.w = lane_ok ? v.w : 0u;
            pf[i] = __builtin_bit_cast(bf16x8, v);
        }
    }
    pv_tile<NDT>(Vs, vf0, pf, r, h, o);
}

DI void nsa_dma(const bf16_t* kbase, int kpitch, const bf16_t* vbase, int vpitch, int krow0, int vcol0, char* Kbuf, char* Vbuf, bool with_v, int lane, int widu) {
    const int rho = 8 * widu + (lane >> 3), c = (lane & 7) ^ ((rho >> 1) & 7);
    glds16(kbase + (size_t)(krow0 + kperm(rho)) * kpitch + c * 8, Kbuf + widu * 1024);
    if (with_v) glds16(vbase + (size_t)rho * vpitch + vcol0 + c * 8, Vbuf + widu * 1024);
}

DI unsigned ord_key(float f) { const unsigned u = __float_as_uint(f); return (u & 0x80000000u) ? ~u : (u | 0x80000000u); }
DI float unord_key(unsigned k) { return __uint_as_float((k & 0x80000000u) ? (k & 0x7fffffffu) : ~k); }
#define CE_DESC(a, b) do { const unsigned hi_ = (a) > (b) ? (a) : (b); const unsigned lo_ = (a) > (b) ? (b) : (a); (a) = hi_; (b) = lo_; } while (0)
DI void sort16_desc(unsigned (&k)[16]) {
#pragma unroll
    for (int size = 2; size <= 16; size <<= 1)
#pragma unroll
        for (int stride = size >> 1; stride > 0; stride >>= 1)
#pragma unroll
            for (int i = 0; i < 16; ++i) {
                const int j = i ^ stride;
                if (j > i) { if ((i & size) == 0) CE_DESC(k[i], k[j]); else CE_DESC(k[j], k[i]); }
            }
}
DI void merge16_desc(unsigned (&v)[16], const unsigned (&k)[16]) {
#pragma unroll
    for (int i = 0; i < 16; ++i) v[i] = v[i] > k[15 - i] ? v[i] : k[15 - i];
#pragma unroll
    for (int stride = 8; stride > 0; stride >>= 1)
#pragma unroll
        for (int i = 0; i < 16; ++i) { const int j = i ^ stride; if (j > i) CE_DESC(v[i], v[j]); }
}
DI void sort8_desc(unsigned (&k)[8]) {
#pragma unroll
    for (int size = 2; size <= 8; size <<= 1)
#pragma unroll
        for (int stride = size >> 1; stride > 0; stride >>= 1)
#pragma unroll
            for (int i = 0; i < 8; ++i) {
                const int j = i ^ stride;
                if (j > i) { if ((i & size) == 0) CE_DESC(k[i], k[j]); else CE_DESC(k[j], k[i]); }
            }
}
template <int CTRL> DI unsigned dpp_mov(unsigned x) { return (unsigned)__builtin_amdgcn_mov_dpp((int)x, CTRL, 0xf, 0xf, true); }

constexpr int NSA_K = 0, NSA_V = 16384, NSA_IMPM = NSA_V + 2 * 64 * VT_PITCH, NSA_IMPC = NSA_IMPM + 64 * 65 * 4, NSA_MASK = NSA_IMPC + 64 * 65 * 4,
              NSA_TAB = NSA_MASK + 512, NSA_OACC = NSA_TAB + 4 * 128 * 4, NSA_VTAB = NSA_OACC + 256 * 68 * 4, NSA_ETAB = NSA_VTAB + 4 * 4 * 272 * 4, NSA_END = NSA_ETAB + 4 * 144 * 4;
constexpr int NSA_VN = 272, NSA_VD0 = 191, NSA_EN = 144, NSA_ED0 = 575;
static_assert(NSA_END <= LDS_BYTES && (NSA_IMPM % 16) == 0 && (NSA_OACC % 16) == 0, "NSA LDS map");
#define NSA_KB(i) (smem + NSA_K + ((i) & 1) * 8192)
#define NSA_VB(i) (smem + NSA_V + ((i) & 1) * (64 * VT_PITCH))

DI void nsa_unit(const Params& P, char* smem, int b, int g, int cur) {
    const int tid = ltid(), lane = tid & 63, wid = tid >> 6, r = lane & 31, h = lane >> 5, hh = r >> 3, ti = r & 7;
    const int tl = 8 * wid + ti, t = 64 * cur + tl;
    const size_t tg = (size_t)b * SEQ + t;
    const int bg = b * 2 + g, head = g * 4 + hh;
    float* impM = (float*)(smem + NSA_IMPM); float* impC = (float*)(smem + NSA_IMPC);
    unsigned long long* mask64 = (unsigned long long*)(smem + NSA_MASK);
    float* tabL = (float*)(smem + NSA_TAB);
    const float* tabG = (const float*)(P.ws + OFF_TAB);
    __syncthreads();
    for (int i = tid; i < 4 * 128; i += NTHREADS) tabL[i] = tabG[(g * 4) * 128 + i];
    {
        const int q = tid >> 7;
        build_vtab<false>((float*)(smem + NSA_VTAB) + q * 4 * NSA_VN, tabG + (g * 4 + q) * 128, NSA_VN, NSA_VD0, tid & 127, 128);
        build_vtab<true>((float*)(smem + NSA_ETAB), tabG, NSA_EN, NSA_ED0, tid, NTHREADS);
    }
    const float* vtab = (const float*)(smem + NSA_VTAB) + hh * 4 * NSA_VN;
    const float* etab = (const float*)(smem + NSA_ETAB);
    for (int i = tid; i < 2 * 64 * 65; i += NTHREADS) impM[i] = 0.f;
    const float* tab = tabL + hh * 128;
    bf16x8 qf[4];
    {
        const bf16_t* qrow = (const bf16_t*)(P.ws + OFF_QN) + tg * 512 + g * 256 + hh * 64 + 8 * h;
#pragma unroll
        for (int ks = 0; ks < 4; ++ks) qf[ks] = *(const bf16x8*)(qrow + 16 * ks);
    }
    const float* gp = (const float*)(P.ws + OFF_GATES) + tg * 24 + head * 3;
    const float gate_c = gp[0], gate_s = gp[1], gate_w = gp[2];
    float* oaccL = (float*)(smem + NSA_OACC) + (tl * 4 + hh) * 68 + 4 * h;
    const int widu = __builtin_amdgcn_readfirstlane(wid);

    const bf16_t* kcmp = (const bf16_t*)(P.ws + OFF_KCMP) + (size_t)bg * 256 * 64;
    const bf16_t* vcmpT = (const bf16_t*)(P.ws + OFF_VCMPT) + (size_t)bg * 64 * 256;
    const int nvis = 4 * cur + 3;
    const int nct = (nvis + 63) >> 6;
    float mc = NEGB, lc = 0.f;
    nsa_dma(kcmp, 64, vcmpT, 256, 0, 0, NSA_KB(0), NSA_VB(0), false, lane, widu);
    __syncthreads();
    for (int ct = 0; ct < nct; ++ct) {
        if (ct + 1 < nct) nsa_dma(kcmp, 64, vcmpT, 256, 64 * (ct + 1), 64 * (ct + 1), NSA_KB(ct + 1), NSA_VB(ct + 1), false, lane, widu);
        f32x16 s0, s1, zero;
#pragma unroll
        for (int i = 0; i < 16; ++i) zero[i] = 0.f;
        int lane_ = lane, tq_ = t - 31 - 16 * 64 * ct;
        asm volatile("" : "+v"(lane_), "+v"(tq_));
        qk_tile(NSA_KB(ct), qf, lane_ & 31, lane_ >> 5, zero, s0, s1);
        if (64 * cur < 1167 + 1024 * ct) mask_tile<2>(s0, s1, lane_ >> 5, tq_, 16, 0x7fffffff, true, tab);
        float mx = tile_max(s0, s1);
        mx = max2(mx, __shfl_xor(mx, 32));
        const float mn = max2(mc, mx);
        const float alpha = __builtin_amdgcn_exp2f(mc - mn);
        mc = mn;
        const float mref = max2(mn, -1e20f);
#pragma unroll
        for (int i = 0; i < 16; ++i) { s0[i] -= mref; s1[i] -= mref; }
        lc = lc * alpha + exp_sum(s0, s1);
        __syncthreads();
    }
    {
        const float lt = lc + __shfl_xor(lc, 32);
        const float inv = lt > 0.f ? 1.0f / lt : 0.f;
        f32x16 oc[2];
#pragma unroll
        for (int i = 0; i < 16; ++i) { oc[0][i] = 0.f; oc[1][i] = 0.f; }
        nsa_dma(kcmp, 64, vcmpT, 256, 0, 0, NSA_KB(0), NSA_VB(0), true, lane, widu);
        f32x16 negmc;
#pragma unroll
        for (int i = 0; i < 16; ++i) negmc[i] = -mc;
        __syncthreads();
        for (int ct = 0; ct < nct; ++ct) {
            if (ct + 1 < nct) nsa_dma(kcmp, 64, vcmpT, 256, 64 * (ct + 1), 64 * (ct + 1), NSA_KB(ct + 1), NSA_VB(ct + 1), true, lane, widu);
            f32x16 s0, s1;
            int lane_ = lane, tq_ = t - 31 - 16 * 64 * ct;
            asm volatile("" : "+v"(lane_), "+v"(tq_));
            qk_tile(NSA_KB(ct), qf, lane_ & 31, lane_ >> 5, negmc, s0, s1);
            bf16x8 vf0[4];
            v_prefetch(NSA_VB(ct), lane_ & 31, lane_ >> 5, vf0);
            if (64 * cur < 1167 + 1024 * ct) mask_tile<2>(s0, s1, lane_ >> 5, tq_, 16, 0x7fffffff, true, tab);
#pragma unroll
            for (int i = 0; i < 16; ++i) {
                s0[i] = __builtin_amdgcn_exp2f(s0[i]) * inv;
                s1[i] = __builtin_amdgcn_exp2f(s1[i]) * inv;
            }
#pragma unroll
            for (int kh = 0; kh < 2; ++kh)
#pragma unroll
                for (int gi = 0; gi < 4; ++gi) {
                    const float p0 = kh ? s1[4 * gi] : s0[4 * gi], p1 = kh ? s1[4 * gi + 1] : s0[4 * gi + 1], p2 = kh ? s1[4 * gi + 2] : s0[4 * gi + 2], p3 = kh ? s1[4 * gi + 3] : s0[4 * gi + 3];
                    float hv = (p0 + p1) + (p2 + 0.5f * p3), cv = 0.5f * p3;
                    hv += __shfl_xor(hv, 8); hv += __shfl_xor(hv, 16);
                    cv += __shfl_xor(cv, 8); cv += __shfl_xor(cv, 16);
                    if (hh == 0) {
                        const int j = 16 * ct + 8 * kh + (gi & 1) + 2 * (lane_ >> 5) + 4 * (gi >> 1);
                        impM[tl * 65 + j] = hv;
                        impC[tl * 65 + j + 1] = cv;
                    }
                }
            bf16x8 pf[4];
            pack_p(s0, s1, pf);
            pv_tile<2>(NSA_VB(ct), vf0, pf, lane_ & 31, lane_ >> 5, oc);
            __syncthreads();
        }
#pragma unroll
        for (int dt = 0; dt < 2; ++dt)
#pragma unroll
            for (int gi = 0; gi < 4; ++gi)
                *(f32x4*)(oaccL + 32 * dt + 8 * gi) = (f32x4){gate_c * oc[dt][4 * gi], gate_c * oc[dt][4 * gi + 1], gate_c * oc[dt][4 * gi + 2], gate_c * oc[dt][4 * gi + 3]};
    }
    {
        const int tk = 8 * wid + (lane >> 3), jb = (lane & 7) * 8;
        unsigned key[8], sk[8];
#pragma unroll
        for (int e = 0; e < 8; ++e) {
            const int j = jb + e;
            const float imp = impM[tk * 65 + j] + impC[tk * 65 + j];
            const float my = (j == 0 || j == cur || j == cur - 1) ? 1e9f : (j <= cur ? imp : NEGB);
            key[e] = (ord_key(my) & ~63u) | (unsigned)(63 - j);
            sk[e] = key[e];
        }
        sort8_desc(sk);
        unsigned v[16], k2[16];
#pragma unroll
        for (int i = 0; i < 8; ++i) { v[i] = sk[i]; v[15 - i] = dpp_mov<0xB1>(sk[i]); }
#pragma unroll
        for (int stride = 8; stride > 0; stride >>= 1)
#pragma unroll
            for (int i = 0; i < 16; ++i) { const int j = i ^ stride; if (j > i) CE_DESC(v[i], v[j]); }
#pragma unroll
        for (int i = 0; i < 16; ++i) k2[i] = dpp_mov<0x4E>(v[i]);
        merge16_desc(v, k2);
#pragma unroll
        for (int i = 0; i < 16; ++i) k2[i] = dpp_mov<0x141>(v[i]);
        merge16_desc(v, k2);
        const unsigned thr = v[15];
        unsigned bits = 0;
#pragma unroll
        for (int e = 0; e < 8; ++e) bits |= (key[e] >= thr && (jb + e) <= cur) ? (1u << e) : 0u;
        ((unsigned char*)mask64)[tk * 8 + (lane & 7)] = (unsigned char)bits;
    }
    __syncthreads();
    const unsigned long long mymask = mask64[tl];
    unsigned long long uni;
    {
        const unsigned long long mm = mask64[lane];
        unsigned lo = (unsigned)mm, hi2 = (unsigned)(mm >> 32);
#pragma unroll
        for (int o = 1; o < 64; o <<= 1) { lo |= __shfl_xor(lo, o); hi2 |= __shfl_xor(hi2, o); }
        uni = ((unsigned long long)hi2 << 32) | lo;
    }
    {
        const bf16_t* kb = (const bf16_t*)(P.ws + OFF_KS) + (size_t)b * SEQ * 128 + g * 64;
        const bf16_t* vb = (const bf16_t*)(P.ws + OFF_VST) + (size_t)bg * 64 * SEQ;
        float l = 0.f;
        f32x16 negm;
#pragma unroll
        for (int i = 0; i < 16; ++i) negm[i] = -M_INIT;
        f32x16 o[2];
#pragma unroll
        for (int i = 0; i < 16; ++i) { o[0][i] = 0.f; o[1][i] = 0.f; }
        int jc = 0;
        while (jc <= cur && !((uni >> jc) & 1ull)) ++jc;
        int jn = jc + 1;
        while (jn <= cur && !((uni >> jn) & 1ull)) ++jn;
        if (jc <= cur) nsa_dma(kb, 128, vb, SEQ, 64 * jc, 64 * jc, NSA_KB(0), NSA_VB(0), true, lane, widu);
        __syncthreads();
        for (int it = 0; jc <= cur; ++it) {
            if (jn <= cur) nsa_dma(kb, 128, vb, SEQ, 64 * jn, 64 * jn, NSA_KB(it + 1), NSA_VB(it + 1), true, lane, widu);
            const bool ok = (mymask >> jc) & 1ull;
            if (jc >= cur - 2) attn_tile<3, 2>(NSA_KB(it), NSA_VB(it), qf, r, h, negm, l, o, t - 64 * jc, NSA_VN, NSA_VD0, ok, vtab);
            else attn_tile<1, 2>(NSA_KB(it), NSA_VB(it), qf, r, h, negm, l, o, 0, 1, 0, ok, tab);
            __syncthreads();
            int jnn = jn + 1;
            while (jnn <= cur && !((uni >> jnn) & 1ull)) ++jnn;
            jc = jn; jn = jnn;
        }
        const float lt = l + __shfl_xor(l, 32);
        const float sc = lt > 0.f ? gate_s / lt : 0.f;
#pragma unroll
        for (int dt = 0; dt < 2; ++dt)
#pragma unroll
            for (int gi = 0; gi < 4; ++gi) {
                f32x4 a = *(const f32x4*)(oaccL + 32 * dt + 8 * gi);
                a.x += sc * o[dt][4 * gi]; a.y += sc * o[dt][4 * gi + 1]; a.z += sc * o[dt][4 * gi + 2]; a.w += sc * o[dt][4 * gi + 3];
                *(f32x4*)(oaccL + 32 * dt + 8 * gi) = a;
            }
    }
    {
        const bf16_t* kb = (const bf16_t*)(P.ws + OFF_KW) + (size_t)b * SEQ * 128 + g * 64;
        const bf16_t* vb = (const bf16_t*)(P.ws + OFF_VWT) + (size_t)bg * 64 * SEQ;
        float l = 0.f;
        f32x16 negm;
#pragma unroll
        for (int i = 0; i < 16; ++i) negm[i] = -M_INIT;
        f32x16 o[2];
#pragma unroll
        for (int i = 0; i < 16; ++i) { o[0][i] = 0.f; o[1][i] = 0.f; }
        const int j0 = cur >= 8 ? cur - 8 : 0;
        nsa_dma(kb, 128, vb, SEQ, 64 * j0, 64 * j0, NSA_KB(0), NSA_VB(0), true, lane, widu);
        __syncthreads();
        for (int j = j0; j <= cur; ++j) {
            const int it = j - j0;
            if (j + 1 <= cur) nsa_dma(kb, 128, vb, SEQ, 64 * (j + 1), 64 * (j + 1), NSA_KB(it + 1), NSA_VB(it + 1), true, lane, widu);
            if (j >= cur - 2) attn_tile<3, 2>(NSA_KB(it), NSA_VB(it), qf, r, h, negm, l, o, t - 64 * j, NSA_VN, NSA_VD0, true, vtab);
            else if (j == cur - 8) attn_tile<3, 2>(NSA_KB(it), NSA_VB(it), qf, r, h, negm, l, o, t - 64 * j, NSA_EN, NSA_ED0, true, etab);
            else attn_tile<0, 2>(NSA_KB(it), NSA_VB(it), qf, r, h, negm, l, o, 0, 1, 0, true, tab);
            __syncthreads();
        }
        const float lt = l + __shfl_xor(l, 32);
        const float sc = lt > 0.f ? gate_w / lt : 0.f;
        bf16_t* mp = (bf16_t*)(P.ws + OFF_H) + tg * DM + g * 256 + hh * 64;
#pragma unroll
        for (int dt = 0; dt < 2; ++dt)
#pragma unroll
            for (int gi = 0; gi < 4; ++gi) {
                f32x4 a = *(const f32x4*)(oaccL + 32 * dt + 8 * gi);
                a.x += sc * o[dt][4 * gi]; a.y += sc * o[dt][4 * gi + 1]; a.z += sc * o[dt][4 * gi + 2]; a.w += sc * o[dt][4 * gi + 3];
                st_bf4(mp + 32 * dt + 8 * gi + 4 * h, a, 1.f);
            }
    }
}

constexpr int DF_K = 0, DF_V = 32768, DF_TAB = DF_V + 2 * 128 * VT_PITCH, DF_O2 = DF_TAB + 4 * 336 * 4, DF_END = DF_O2 + 128 * 129 * 4;
constexpr int DF_VN = 336, DF_VD0 = 223;
static_assert(DF_END <= LDS_BYTES && (DF_TAB % 16) == 0, "diff LDS map");

DI void diff_unit(const Params& P, char* smem, int b, int hd, int qi, float lam) {
    const int tid = ltid(), lane = tid & 63, wid = tid >> 6, r = lane & 31, h = lane >> 5, qs = wid & 3, mp = wid >> 2;
    const int t0 = 128 * qi, t = t0 + 32 * qs + r;
    const size_t tg = (size_t)b * SEQ + t;
    float* tabL = (float*)(smem + DF_TAB);
    float* o2b = (float*)(smem + DF_O2);
    __syncthreads();
    build_vtab<false>(tabL, (const float*)(P.ws + OFF_TAB) + (8 + hd) * 128, DF_VN, DF_VD0, tid, NTHREADS);
    bf16x8 qf[4];
    {
        const bf16_t* qrow = (const bf16_t*)(P.ws + OFF_DQ) + tg * 512 + (hd * 2 + mp) * 64 + 8 * h;
#pragma unroll
        for (int ks = 0; ks < 4; ++ks) qf[ks] = *(const bf16x8*)(qrow + 16 * ks);
    }
    const bf16_t* kb = (const bf16_t*)(P.ws + OFF_DK) + (size_t)b * SEQ * 512 + hd * 128;
    const bf16_t* vb = (const bf16_t*)(P.ws + OFF_DVT) + (size_t)(b * 4 + hd) * 128 * SEQ;
    const int widu = __builtin_amdgcn_readfirstlane(wid);
#define DF_DMA(j, bi) do { _Pragma("unroll") for (int i_ = 0; i_ < 2; ++i_) { const int q_ = 2 * widu + i_; \
        const int rho_ = 8 * (q_ & 7) + (lane >> 3), ck_ = (lane & 7) ^ ((rho_ >> 1) & 7); \
        glds16(kb + (size_t)(64 * (j) + kperm(rho_)) * 512 + (q_ >> 3) * 64 + ck_ * 8, smem + DF_K + ((bi) & 1) * 16384 + q_ * 1024); \
        const int d_ = 8 * q_ + (lane >> 3), cv_ = (lane & 7) ^ ((d_ >> 1) & 7); \
        glds16(vb + (size_t)d_ * SEQ + 64 * (j) + cv_ * 8, smem + DF_V + ((bi) & 1) * (128 * VT_PITCH) + q_ * 1024); } } while (0)
    float l = 0.f;
    f32x16 negm;
#pragma unroll
    for (int i = 0; i < 16; ++i) negm[i] = -M_INIT;
    f32x16 o[4];
#pragma unroll
    for (int dt = 0; dt < 4; ++dt)
#pragma unroll
        for (int i = 0; i < 16; ++i) o[dt][i] = 0.f;
    const int ntile = 2 * qi + 2;
    const int tmin = t0 + 32 * qs;
    DF_DMA(0, 0);
    __syncthreads();
    for (int j = 0; j < ntile; ++j) {
        if (j + 1 < ntile) DF_DMA(j + 1, j + 1);
        const char* Ks = smem + DF_K + (j & 1) * 16384 + mp * 8192;
        const char* Vs = smem + DF_V + (j & 1) * (128 * VT_PITCH);
        if (64 * j <= tmin + 31) {
            if (64 * j + 63 + 128 > tmin) attn_tile<3, 4>(Ks, Vs, qf, r, h, negm, l, o, t - 64 * j, DF_VN, DF_VD0, true, tabL);
            else attn_tile<0, 4>(Ks, Vs, qf, r, h, negm, l, o, 0, 1, 0, true, tabL);
        }
        __syncthreads();
    }
#undef DF_DMA
    const float lt = l + __shfl_xor(l, 32);
    const float inv = 1.0f / lt;
    const int tloc = 32 * qs + r;
    if (mp == 1) {
#pragma unroll
        for (int dt = 0; dt < 4; ++dt)
#pragma unroll
            for (int i = 0; i < 16; ++i) o2b[tloc * 129 + 32 * dt + crow(i, h)] = lam * inv * o[dt][i];
    }
    __syncthreads();
    if (mp == 0) {
        float ss = 0.f;
#pragma unroll
        for (int dt = 0; dt < 4; ++dt)
#pragma unroll
            for (int i = 0; i < 16; ++i) { const float v = o[dt][i] * inv - o2b[tloc * 129 + 32 * dt + crow(i, h)]; o[dt][i] = v; ss += v * v; }
        ss += __shfl_xor(ss, 32);
        const float rn = __builtin_amdgcn_rsqf(ss * (1.0f / 128.0f) + RMS_EPS) * 0.8f;
        bf16_t* mpx = (bf16_t*)(P.ws + OFF_H) + tg * DM + 512 + hd * 128;
#pragma unroll
        for (int dt = 0; dt < 4; ++dt)
#pragma unroll
            for (int gi = 0; gi < 4; ++gi) {
                const int d = 32 * dt + 8 * gi + 4 * h;
                const f32x4 gg = *(const f32x4*)(P.subln_g + d);
                f32x4 v = {o[dt][4 * gi] * rn * gg.x, o[dt][4 * gi + 1] * rn * gg.y, o[dt][4 * gi + 2] * rn * gg.z, o[dt][4 * gi + 3] * rn * gg.w};
                st_bf4(mpx + d, v, 1.f);
            }
    }
}

DI void phase_attention(const Params& P, char* smem) {
    float lam;
    {
        const int lane = ltid() & 63;
        const float a = wave_sum(P.lam_q1[lane] * P.lam_k1[lane]);
        const float b2 = wave_sum(P.lam_q2[lane] * P.lam_k2[lane]);
        lam = __expf(a) - __expf(b2) + 0.2f;
    }
    for (int u = blockIdx.x; u < 4096; u += gridDim.x) {
        const int k = u >> 1;
        if (((u + (u >> 8)) & 1) == 0) {
            const int qi = 31 - (k >> 6), bh = k & 63;
#ifndef REP_KIND
#define REP_KIND 0
#endif
            for (int rp = 0; rp < (REP_KIND == 1 ? 2 : 1); ++rp)
            diff_unit(P, smem, bh >> 2, bh & 3, qi, lam);
        } else {
            const int cur = 63 - (k >> 5), bgi = k & 31;
            for (int rp = 0; rp < (REP_KIND == 2 ? 2 : 1); ++rp)
            nsa_unit(P, smem, bgi >> 1, bgi & 1, cur);
        }
    }
}

#define INS16(v, c) do { _Pragma("unroll") for (int e_ = 0; e_ < 16; ++e_) { const unsigned hi_ = (v)[e_] > (c) ? (v)[e_] : (c); (c) = (v)[e_] > (c) ? (c) : (v)[e_]; (v)[e_] = hi_; } } while (0)
constexpr int RT_SK = 0, RT_SCR = 65536, RT_END = RT_SCR + 8 * 2048;

DI void phase_retrieval(const Params& P, char* smem, int task0 = 0, int task1 = 2048 * 8, int bi = blockIdx.x, int nb = gridDim.x) {
    const int tid = ltid(), lane = tid & 63, wid = tid >> 6, r = lane & 31, h = lane >> 5;
    __syncthreads();
    {
        const bf16_t* sk = (const bf16_t*)(P.ws + OFF_SK);
        for (int i = tid; i < 2 * 128 * 16; i += NTHREADS) {
            const int row = i >> 4, c = i & 15;
            *(u32x4*)(smem + RT_SK + row * 256 + ((c ^ (row & 15)) << 4)) = *(const u32x4*)(sk + (size_t)row * 128 + c * 8);
        }
    }
    __syncthreads();
    unsigned char* scr = (unsigned char*)(smem + RT_SCR) + wid * 2048 + lane * 32;
    const int gw = bi * 8 + wid, NGW = nb * 8;
    for (int task = task0 + gw; task < task1; task += NGW) {
        const int tt = task >> 3, hp = task & 7;
        const size_t tok = (size_t)tt * 32 + r;
        unsigned L[2][16];
#pragma unroll
        for (int p = 0; p < 2; ++p) {
            bf16x8 qf[8];
            {
                const bf16_t* qb = (const bf16_t*)(P.ws + OFF_QP) + ((size_t)tt * 16 + hp * 2 + p) * 4096 + (size_t)(h * 32 + r) * 8;
#pragma unroll
                for (int ks = 0; ks < 8; ++ks) qf[ks] = *(const bf16x8*)(qb + ks * 512);
            }
            unsigned v[16];
#pragma unroll
            for (int kt = 0; kt < 4; ++kt) {
                f32x16 acc;
#pragma unroll
                for (int i = 0; i < 16; ++i) acc[i] = 0.f;
                const char* krow = smem + RT_SK + (p * 128 + 32 * kt + r) * 256;
                bf16x8 kf[8];
#pragma unroll
                for (int ks = 0; ks < 8; ++ks) kf[ks] = *(const bf16x8*)(krow + (((2 * ks + h) ^ (r & 15)) << 4));
#pragma unroll
                for (int ks = 0; ks < 8; ++ks) acc = MFMA32(kf[ks], qf[ks], acc);
                unsigned k[16];
#pragma unroll
                for (int i = 0; i < 16; ++i) k[i] = (ord_key(acc[i]) & ~127u) | (unsigned)(127 - (32 * kt + crow(i, h)));
                sort16_desc(k);
                if (kt == 0) {
#pragma unroll
                    for (int e = 0; e < 16; ++e) v[e] = k[e];
                } else merge16_desc(v, k);
            }
            unsigned w2[16];
#pragma unroll
            for (int e = 0; e < 16; ++e) w2[e] = (unsigned)__shfl_xor((int)v[e], 32);
            merge16_desc(v, w2);
#pragma unroll
            for (int e = 0; e < 16; ++e) L[p][e] = v[e];
        }
        float s0[16], s1[16];
#pragma unroll
        for (int e = 0; e < 16; ++e) { s0[e] = unord_key(L[0][e] & ~127u); s1[e] = unord_key(L[1][e] & ~127u); }
        unsigned f[16];
        {
            unsigned ca[16], cb[16];
#pragma unroll
            for (int e = 0; e < 16; ++e) { ca[e] = 0u; cb[e] = 0u; }
            const unsigned hm2 = 0u - (unsigned)h;
            int n = 0;
            unsigned prev = 0u;
#pragma unroll
            for (int a = 0; a < 16; ++a)
#pragma unroll
                for (int bb = 0; bb < 16; ++bb)
                    if ((a + 1) * (bb + 1) <= 16) {
                        const unsigned c = (ord_key(s0[a] + s1[bb]) & ~255u) | (unsigned)(255 - (a * 16 + bb));
                        if (n & 1) { const unsigned sel = prev ^ ((prev ^ c) & hm2); const int m = n >> 1; if (m < 16) ca[m] = sel; else cb[m - 16] = sel; }
                        prev = c;
                        ++n;
                    }
            sort16_desc(ca); sort16_desc(cb);
            merge16_desc(ca, cb);
            unsigned w2[16];
#pragma unroll
            for (int e = 0; e < 16; ++e) w2[e] = (unsigned)__shfl_xor((int)ca[e], 32);
            merge16_desc(ca, w2);
#pragma unroll
            for (int e = 0; e < 16; ++e) f[e] = ca[e];
        }
#pragma unroll
        for (int e = 0; e < 16; e += 4) {
            const unsigned i0 = (127u - (L[0][e] & 127u)) | ((127u - (L[0][e + 1] & 127u)) << 8) | ((127u - (L[0][e + 2] & 127u)) << 16) | ((127u - (L[0][e + 3] & 127u)) << 24);
            const unsigned i1 = (127u - (L[1][e] & 127u)) | ((127u - (L[1][e + 1] & 127u)) << 8) | ((127u - (L[1][e + 2] & 127u)) << 16) | ((127u - (L[1][e + 3] & 127u)) << 24);
            *(unsigned*)(scr + e) = i0; *(unsigned*)(scr + 16 + e) = i1;
        }
        const float best0 = unord_key(f[0] & ~255u);
        float ex[16]; float sum = 0.f;
#pragma unroll
        for (int e = 0; e < 16; ++e) { ex[e] = __expf(unord_key(f[e] & ~255u) - best0); sum += ex[e]; }
        const float inv = 1.0f / sum;
        int* eo = (int*)(P.ws + OFF_EID) + tok * 128 + hp * 16 + 8 * h;
        float* go = (float*)(P.ws + OFF_GW) + tok * 128 + hp * 16 + 8 * h;
        int eid[8]; float gg[8];
        const unsigned hm = 0u - (unsigned)h;
#pragma unroll
        for (int e = 0; e < 8; ++e) {
            const unsigned key = f[e] ^ ((f[e] ^ f[8 + e]) & hm);
            const int pos = 255 - (int)(key & 255u), a = pos >> 4, bb = pos & 15;
            eid[e] = (int)scr[a] * 128 + (int)scr[16 + bb];
            const unsigned xe = __float_as_uint(ex[e]) ^ ((__float_as_uint(ex[e]) ^ __float_as_uint(ex[8 + e])) & hm);
            gg[e] = __uint_as_float(xe) * inv;
        }
        *(int4*)(eo) = make_int4(eid[0], eid[1], eid[2], eid[3]); *(int4*)(eo + 4) = make_int4(eid[4], eid[5], eid[6], eid[7]);
        *(f32x4*)(go) = (f32x4){gg[0], gg[1], gg[2], gg[3]}; *(f32x4*)(go + 4) = (f32x4){gg[4], gg[5], gg[6], gg[7]};
    }
}

DI float ub0(unsigned w) { return (float)(w & 0xffu); }
DI float ub1(unsigned w) { return (float)((w >> 8) & 0xffu); }
DI float ub2(unsigned w) { return (float)((w >> 16) & 0xffu); }
DI float ub3(unsigned w) { return (float)(w >> 24); }

typedef _Float16 h16x2_t __attribute__((ext_vector_type(2)));
DI float dot2h(unsigned a, unsigned b, float c) { return __builtin_amdgcn_fdot2(__builtin_bit_cast(h16x2_t, a), __builtin_bit_cast(h16x2_t, b), c, false); }
DI float dot16_u8(const unsigned (&hp)[8], u32x4 w) {
    float a = dot2h(hp[0], __builtin_amdgcn_perm(0x64646464u, w.x, 0x04010400u), 0.f);
    a = dot2h(hp[1], __builtin_amdgcn_perm(0x64646464u, w.x, 0x04030402u), a);
    a = dot2h(hp[2], __builtin_amdgcn_perm(0x64646464u, w.y, 0x04010400u), a);
    a = dot2h(hp[3], __builtin_amdgcn_perm(0x64646464u, w.y, 0x04030402u), a);
    a = dot2h(hp[4], __builtin_amdgcn_perm(0x64646464u, w.z, 0x04010400u), a);
    a = dot2h(hp[5], __builtin_amdgcn_perm(0x64646464u, w.z, 0x04030402u), a);
    a = dot2h(hp[6], __builtin_amdgcn_perm(0x64646464u, w.w, 0x04010400u), a);
    a = dot2h(hp[7], __builtin_amdgcn_perm(0x64646464u, w.w, 0x04030402u), a);
    return a;
}
DI void phase_experts(const Params& P, int row0 = 0, int row1 = NTOK, int bi = blockIdx.x, int nb = gridDim.x) {
    const int tid = ltid(), lane = tid & 63, wid = tid >> 6;
    const int gw = bi * 8 + wid, NGW = nb * 8;
    const unsigned char* U = P.ws + OFF_U;
    const unsigned char* V = P.ws + OFF_V;
    const float* US = (const float*)(P.ws + OFF_US);
    const float* VS = (const float*)(P.ws + OFF_VS);
    const float* mod = (const float*)(P.ws + OFF_MOD);
    for (int row = row0 + gw; row < row1; row += NGW) {
        const int b = row >> 12;
        const bf16_t* hrow = (const bf16_t*)(P.ws + OFF_H) + (size_t)row * DM + 16 * lane;
        unsigned hq[8]; float hs = 0.f;
        {
            const u32x4 h0 = *(const u32x4*)(hrow), h1 = *(const u32x4*)(hrow + 8);
            const unsigned hw[8] = {h0.x, h0.y, h0.z, h0.w, h1.x, h1.y, h1.z, h1.w};
#pragma unroll
            for (int i = 0; i < 8; ++i) {
                const _Float16 a = (_Float16)bf_lo(hw[i]), b2 = (_Float16)bf_hi(hw[i]);
                hs += (float)a + (float)b2;
                h16x2_t pv = {a, b2};
                hq[i] = __builtin_bit_cast(unsigned, pv);
            }
        }
        const float hsum128 = 1152.0f * wave_sum(hs);
        const int* eidp = (const int*)(P.ws + OFF_EID) + (size_t)row * 128;
        const float* gwp = (const float*)(P.ws + OFF_GW) + (size_t)row * 128;
        float* cop = (float*)(P.ws + OFF_CO) + (size_t)row * 128;
        for (int hp = 0; hp < 8; ++hp) {
            const int eme = eidp[hp * 16 + (lane & 15)];
            const float gme = gwp[hp * 16 + (lane & 15)];
            const float sume = US[eme], svme = VS[eme];
            int eid[16];
#pragma unroll
            for (int e = 0; e < 16; ++e) eid[e] = __builtin_amdgcn_readlane(eme, e);
            float part[16];
            {
                u32x4 uw[16];
#pragma unroll
                for (int e = 0; e < 16; ++e) uw[e] = *(const u32x4*)(U + (size_t)eid[e] * DM + 16 * lane);
#pragma unroll
                for (int e = 0; e < 16; ++e) part[e] = dot16_u8(hq, uw[e]);
            }
            float q8[8], q4[4], q2[2], q1;
            {
                const bool up = (lane & 32) != 0;
#pragma unroll
                for (int i = 0; i < 8; ++i) { const float send = up ? part[i] : part[i + 8], keep = up ? part[i + 8] : part[i]; q8[i] = keep + __shfl_xor(send, 32); }
            }
            {
                const bool up = (lane & 16) != 0;
#pragma unroll
                for (int i = 0; i < 4; ++i) { const float send = up ? q8[i] : q8[i + 4], keep = up ? q8[i + 4] : q8[i]; q4[i] = keep + __shfl_xor(send, 16); }
            }
            {
                const bool up = (lane & 8) != 0;
#pragma unroll
                for (int i = 0; i < 2; ++i) { const float send = up ? q4[i] : q4[i + 2], keep = up ? q4[i + 2] : q4[i]; q2[i] = keep + __shfl_xor(send, 8); }
            }
            {
                const bool up = (lane & 4) != 0;
                const float send = up ? q2[0] : q2[1], keep = up ? q2[1] : q2[0];
                q1 = keep + __shfl_xor(send, 4);
            }
            q1 += __shfl_xor(q1, 2);
            q1 += __shfl_xor(q1, 1);
            const int emine = ((lane >> 5) & 1) * 8 + ((lane >> 4) & 1) * 4 + ((lane >> 3) & 1) * 2 + ((lane >> 2) & 1);
            const float gmine = __shfl(gme, emine), sumine = __shfl(sume, emine), svmine = __shfl(svme, emine);
            const float coef = gmine * gelu_tanh(sumine * (q1 - hsum128)) * svmine;
            if ((lane & 3) == 0) cop[hp * 16 + emine] = coef;
        }
    }
    asm volatile("s_waitcnt vmcnt(0)" ::: "memory");
    for (int row = row0 + gw; row < row1; row += NGW) {
        const int b = row >> 12;
        float out[16];
#pragma unroll
        for (int i = 0; i < 16; ++i) out[i] = 0.f;
        float csum = 0.f;
        const int* eidp = (const int*)(P.ws + OFF_EID) + (size_t)row * 128;
        const float* cop = (const float*)(P.ws + OFF_CO) + (size_t)row * 128;
        for (int hp = 0; hp < 8; ++hp) {
            const int eme = eidp[hp * 16 + (lane & 15)];
            const float cme = cop[hp * 16 + (lane & 15)];
            int eid[16];
#pragma unroll
            for (int e = 0; e < 16; ++e) eid[e] = __builtin_amdgcn_readlane(eme, e);
            u32x4 vw[16];
#pragma unroll
            for (int e = 0; e < 16; ++e) vw[e] = *(const u32x4*)(V + (size_t)eid[e] * DM + 16 * lane);
#pragma unroll
            for (int e = 0; e < 16; ++e) {
                const float ce = __builtin_bit_cast(float, __builtin_amdgcn_readlane(__builtin_bit_cast(int, cme), e));
                csum += ce;
                out[0] += ce * ub0(vw[e].x); out[1] += ce * ub1(vw[e].x); out[2] += ce * ub2(vw[e].x); out[3] += ce * ub3(vw[e].x);
                out[4] += ce * ub0(vw[e].y); out[5] += ce * ub1(vw[e].y); out[6] += ce * ub2(vw[e].y); out[7] += ce * ub3(vw[e].y);
                out[8] += ce * ub0(vw[e].z); out[9] += ce * ub1(vw[e].z); out[10] += ce * ub2(vw[e].z); out[11] += ce * ub3(vw[e].z);
                out[12] += ce * ub0(vw[e].w); out[13] += ce * ub1(vw[e].w); out[14] += ce * ub2(vw[e].w); out[15] += ce * ub3(vw[e].w);
            }
        }
        const float cb = 128.0f * csum;
        const bf16_t* x1r = (const bf16_t*)(P.ws + OFF_X1) + (size_t)row * DM + 16 * lane;
        const u32x4 xa = *(const u32x4*)(x1r), xb = *(const u32x4*)(x1r + 8);
        const float x1f[16] = {bf_lo(xa.x), bf_hi(xa.x), bf_lo(xa.y), bf_hi(xa.y), bf_lo(xa.z), bf_hi(xa.z), bf_lo(xa.w), bf_hi(xa.w),
                               bf_lo(xb.x), bf_hi(xb.x), bf_lo(xb.y), bf_hi(xb.y), bf_lo(xb.z), bf_hi(xb.z), bf_lo(xb.w), bf_hi(xb.w)};
        const float* gf = mod + (size_t)b * 6144 + 5 * 1024 + 16 * lane;
        float x2[16]; float ss = 0.f;
#pragma unroll
        for (int q = 0; q < 4; ++q) {
            const f32x4 xv = {x1f[4 * q], x1f[4 * q + 1], x1f[4 * q + 2], x1f[4 * q + 3]}, g = *(const f32x4*)(gf + 4 * q);
            const int o = 4 * q;
            x2[o] = xv.x + g.x * (out[o] - cb); x2[o + 1] = xv.y + g.y * (out[o + 1] - cb); x2[o + 2] = xv.z + g.z * (out[o + 2] - cb); x2[o + 3] = xv.w + g.w * (out[o + 3] - cb);
            ss += (x2[o] * x2[o] + x2[o + 1] * x2[o + 1]) + (x2[o + 2] * x2[o + 2] + x2[o + 3] * x2[o + 3]);
        }
        const float rstd = __builtin_amdgcn_rsqf(wave_sum(ss) * (1.0f / DM) + RMS_EPS);
        float* orow = P.out + (size_t)row * DM + 16 * lane;
#pragma unroll
        for (int q = 0; q < 4; ++q) {
            const int o = 4 * q;
            const f32x4 g = *(const f32x4*)(P.final_g + 16 * lane + 4 * q);
            *(f32x4*)(orow + 4 * q) = (f32x4){x2[o] * rstd * g.x, x2[o + 1] * rstd * g.y, x2[o + 2] * rstd * g.z, x2[o + 3] * rstd * g.w};
        }
    }
}

#define XB_TMO      128
#define XB_XCNT(j)  (256  + 64 * (j))
#define XB_XSUB(j)  (1280 + 64 * (j))
#define XB_XGEN(j)  (2304 + 64 * (j))
#define XB_TOP      3328
#define XB_TOPGEN   3392
#define XCD_BAR_WORDS 3456
#define XB_SPIN_CAP (1u << 18)

__device__ __forceinline__ unsigned xb_ld(unsigned* p)              { return __hip_atomic_load(p, __ATOMIC_RELAXED, __HIP_MEMORY_SCOPE_AGENT); }
__device__ __forceinline__ unsigned xb_add(unsigned* p, unsigned v) { return __hip_atomic_fetch_add(p, v, __ATOMIC_RELAXED, __HIP_MEMORY_SCOPE_AGENT); }
__device__ __forceinline__ unsigned xb_xcc_id() { return (unsigned)__builtin_amdgcn_s_getreg((3 << 11) | 20) & 0xFu; }
#define XB_SPIN(cond, bar) do { unsigned _sp = 0; while (cond) { __builtin_amdgcn_s_sleep(1); \
    if ((++_sp & 255u) == 0u) { if (xb_ld(&(bar)[XB_TMO])) break; if (_sp > XB_SPIN_CAP) { atomicAdd(&(bar)[XB_TMO], 1u); break; } } } } while (0)

struct XcdBarrier {
    unsigned* bar; unsigned x;
    volatile LAS3 unsigned* st;
};

__device__ __forceinline__ XcdBarrier xcd_barrier_post(unsigned* bar, volatile LAS3 unsigned* st) {
    XcdBarrier b; b.bar = bar; b.x = xb_xcc_id(); b.st = st;
    if (threadIdx.x == 0) (void)xb_add(&bar[XB_XCNT(b.x)], 1u);
    return b;
}
__device__ __forceinline__ void xcd_barrier_complete(unsigned* bar, unsigned x, unsigned& nloc, unsigned& nx) {
    const unsigned G = gridDim.x * gridDim.y * gridDim.z;
    unsigned sum, cnt, mine, sp = 0u;
    for (;;) {
        sum = 0u; cnt = 0u; mine = 0u;
#pragma unroll
        for (unsigned j = 0; j < 16; ++j) { const unsigned c = xb_ld(&bar[XB_XCNT(j)]); sum += c; cnt += (c > 0u) ? 1u : 0u; mine = (j == x) ? c : mine; }
        if (sum == G) break;
        __builtin_amdgcn_s_sleep(1);
        if ((++sp & 255u) == 0u) { if (xb_ld(&bar[XB_TMO])) break; if (sp > XB_SPIN_CAP) { atomicAdd(&bar[XB_TMO], 1u); break; } }
    }
    nloc = mine > 0u ? mine : 1u; nx = cnt > 0u ? cnt : 1u;
}

__device__ __forceinline__ void xcd_barrier(const XcdBarrier& b) {
    asm volatile("s_waitcnt vmcnt(0)" ::: "memory");
    __syncthreads();
    if (threadIdx.x == 0) {
        unsigned* bar = b.bar;
        __builtin_amdgcn_s_waitcnt(0);
        unsigned nloc = b.st[0], nx = b.st[1];
        if (nloc == 0u) { xcd_barrier_complete(bar, b.x, nloc, nx); b.st[0] = nloc; b.st[1] = nx; }
        const unsigned old = xb_add(&bar[XB_XSUB(b.x)], 1u);
        const unsigned gen = old / nloc;
        if (old + 1u == (gen + 1u) * nloc) {
            __builtin_amdgcn_fence(__ATOMIC_RELEASE, "agent");
            asm volatile("s_waitcnt vmcnt(0)" ::: "memory");
            const unsigned og = xb_add(&bar[XB_TOP], 1u);
            const unsigned tg = og / nx;
            if (og + 1u == (tg + 1u) * nx) xb_add(&bar[XB_TOPGEN], 1u);
            else XB_SPIN(xb_ld(&bar[XB_TOPGEN]) == tg, bar);
            __builtin_amdgcn_fence(__ATOMIC_ACQUIRE, "agent");
            xb_add(&bar[XB_XGEN(b.x)], 1u);
            asm volatile("s_waitcnt vmcnt(0)" ::: "memory");
        } else {
            XB_SPIN(xb_ld(&bar[XB_XGEN(b.x)]) == gen, bar);
            __builtin_amdgcn_fence(__ATOMIC_ACQUIRE, "agent");
            asm volatile("s_waitcnt vmcnt(0)" ::: "memory");
        }
    }
    __syncthreads();
}


#define XB_GRP 3520
__device__ __forceinline__ void group_barrier(unsigned* bar, unsigned members, unsigned& target) {
    asm volatile("s_waitcnt vmcnt(0)" ::: "memory");
    __syncthreads();
    target += members;
    if (threadIdx.x == 0) {
        __builtin_amdgcn_s_waitcnt(0);
        __builtin_amdgcn_fence(__ATOMIC_RELEASE, "agent");
        asm volatile("s_waitcnt vmcnt(0)" ::: "memory");
        (void)xb_add(&bar[XB_GRP], 1u);
        XB_SPIN(xb_ld(&bar[XB_GRP]) < target, bar);
        __builtin_amdgcn_fence(__ATOMIC_ACQUIRE, "agent");
        asm volatile("s_waitcnt vmcnt(0)" ::: "memory");
    }
    __syncthreads();
}

constexpr int N_PHASES = 11;
__global__ void __launch_bounds__(NTHREADS) fwd_kernel(Params P) {
    extern __shared__ __attribute__((aligned(16))) char smem[];
    cg::grid_group grid = cg::this_grid();
    const int lo = P.ph_lo, hi = P.ph_hi;
    const int G = gridDim.x, bid = blockIdx.x;
#ifndef REP_PHASE
#define REP_PHASE -1
#endif
#define IN(k) (lo <= (k) && (k) < hi)
#define REPS(k) for (int rep_ = 0; rep_ < ((k) == REP_PHASE ? 2 : 1); ++rep_)
    volatile LAS3 unsigned* bst = (volatile LAS3 unsigned*)((LAS3 char*)smem + (LDS_BYTES - 16));
    if (threadIdx.x < 2) bst[threadIdx.x] = 0u;
    __syncthreads();
    XcdBarrier xbar = xcd_barrier_post((unsigned*)(P.ws + OFF_BAR), bst);
    if (lo > 1000) grid.sync();
#define SEAM(k) do { if (IN(k) && IN((k) + 1)) xcd_barrier(xbar); } while (0)
    const bool defer_late = G > 128 && lo == 0 && hi > 3;
    REPS(0) if (IN(0)) { if (defer_late) phase_prologue<0>(P, smem, bid, G); else phase_prologue<2>(P, smem, bid, G); }
    SEAM(0);
    REPS(1) if (IN(1)) phase_normmod<false>(P, P.x, P.norm1_g, 0, 1, (bf16_t*)(P.ws + OFF_H));
    SEAM(1);
    REPS(2) if (IN(2)) {
        {
            const pg8::Gemm g{(const bf16_t*)(P.ws + OFF_H), (const bf16_t*)(P.ws + OFF_WINT), NTOK, 2304, DM};
            pg8::StaticOrder S; S.init(NTOK, 2304, G, bid);
            const EpiPg8<EpiInProj> E{EpiInProj{P.ws}};
            pg8::gemm_phase<EpiPg8<EpiInProj>, pg8::StaticOrder, true, true>((PG8_LAS unsigned char*)smem, g, S, E);
        }
        {
            const pg8::Gemm g{(const bf16_t*)(P.ws + OFF_WINT) + (size_t)2304 * DM, (const bf16_t*)(P.ws + OFF_H), 768, NTOK, DM};
            pg8::StaticOrder S; S.init(768, NTOK, G, bid);
            const EpiPg8<EpiInProjT> E{EpiInProjT{P.ws}};
            pg8::gemm_phase<EpiPg8<EpiInProjT>, pg8::StaticOrder, true, true>((PG8_LAS unsigned char*)smem, g, S, E);
        }
    }
    SEAM(2);
    REPS(3) if (IN(3)) {
        if (defer_late && bid >= 128) phase_prologue<1>(P, smem, bid - 128, G - 128);
        for (int u = bid; u < 2 * 32 * 2; u += (defer_late ? 128 : G)) {
            if (defer_late && bid >= 128) break;
            const int kv = u >> 6, mt = (u >> 1) & 31, nt = u & 1;
            const ACmp af{(const bf16_t*)(P.ws + (kv ? OFF_VC : OFF_KC))};
            const EpiCmp1 epi{(bf16_t*)(P.ws + OFF_HID) + (size_t)kv * 8192 * 256, (const float*)(P.ws + OFF_PB) + kv * 256};
            gemm_tile<false>(smem, af, (const bf16_t*)(P.ws + OFF_W1T) + (size_t)kv * 256 * 2048, 2048, mt * 256, nt * 128, 32, epi);
        }
    }
    SEAM(3);
    REPS(4) if (IN(4)) {
        for (int u = bid; u < 2 * 32; u += G) {
            const int kv = u >> 5, mt = u & 31;
            const ARowMajor af{(const bf16_t*)(P.ws + OFF_HID) + (size_t)kv * 8192 * 256, 256};
            const EpiCmp2 epi{(bf16_t*)(P.ws + OFF_KCMP), (bf16_t*)(P.ws + OFF_VCMPT)};
            const bf16_t* Bt = (const bf16_t*)(P.ws + OFF_W2T) + (size_t)kv * 128 * 256;
            if (kv) gemm_tile<true>(smem, af, Bt, 256, mt * 256, 0, 4, epi);
            else gemm_tile<false>(smem, af, Bt, 256, mt * 256, 0, 4, epi);
        }
    }
    SEAM(4);
    REPS(5) if (IN(5)) phase_attention(P, smem);
    SEAM(5);
    REPS(6) if (IN(6)) {
        const pg8::Gemm g{(const bf16_t*)(P.ws + OFF_H), (const bf16_t*)(P.ws + OFF_WOUTT), NTOK, DM, DM};
        pg8::StaticOrder S; S.init(NTOK, DM, G, bid);
        const EpiPg8<EpiOutProj> E{EpiOutProj{P.x, (const float*)(P.ws + OFF_MOD), (bf16_t*)(P.ws + OFF_X1)}};
        pg8::gemm_phase<EpiPg8<EpiOutProj>, pg8::StaticOrder, true, true>((PG8_LAS unsigned char*)smem, g, S, E);
    }
    SEAM(6);
    if (IN(7)) {
        constexpr int NCH = 3;
        constexpr int TB[NCH + 1] = {0, 64 * 256, 152 * 256, NTOK};
        const int PIPE_X = G >= 128 ? G / 4 : 0;
        unsigned gtarget = 0u;
        for (int k = 0; k <= NCH; ++k) {
            const bool hasX = k < NCH, hasE = k >= 1;
            const bool mixed = hasX && hasE && PIPE_X > 0;
            if (!mixed && hasE) phase_experts(P, TB[k - 1], TB[k], bid, G);
            if (mixed && bid < G - PIPE_X) phase_experts(P, TB[k - 1], TB[k], bid, G - PIPE_X);
            if (hasX && (!mixed || bid >= G - PIPE_X)) {
                const int bi = mixed ? bid - (G - PIPE_X) : bid, nb = mixed ? PIPE_X : G;
                const int r0 = TB[k], r1 = TB[k + 1];
                phase_normmod<true>(P, P.ws + OFF_X1, P.norm2_g, 3, 4, (bf16_t*)(P.ws + OFF_H), r0, r1, bi, nb);
                if (mixed) group_barrier((unsigned*)(P.ws + OFF_BAR), (unsigned)PIPE_X, gtarget); else xcd_barrier(xbar);
                {
                    const pg8::Gemm g{(const bf16_t*)(P.ws + OFF_H) + (size_t)r0 * DM, (const bf16_t*)(P.ws + OFF_WQT), r1 - r0, 2048, DM};
                    pg8::StaticOrder S; S.init(r1 - r0, 2048, nb, bi);
                    const EpiPg8<EpiWq> E{EpiWq{(bf16_t*)(P.ws + OFF_QP) + (size_t)(r0 >> 5) * 16 * 4096}};
                    pg8::gemm_phase<EpiPg8<EpiWq>, pg8::StaticOrder, true, true>((PG8_LAS unsigned char*)smem, g, S, E);
                }
                if (mixed) group_barrier((unsigned*)(P.ws + OFF_BAR), (unsigned)PIPE_X, gtarget); else xcd_barrier(xbar);
                phase_retrieval(P, smem, (r0 >> 5) * 8, (r1 >> 5) * 8, bi, nb);
            }
            if (k < NCH) xcd_barrier(xbar);
        }
    }
#undef IN
#undef SEAM
}

extern "C" void kernel_launch(void* const* d_in, const int* in_sizes, int n_in, void* d_out, int out_size, void* d_ws, size_t ws_size, hipStream_t stream) {
    static int grid = 0;
    if (grid == 0) {
        if (n_in != 22 || in_sizes[0] != NTOK * DM || out_size != NTOK * DM || ws_size < WS_NEED) {
            fprintf(stderr, "kernel_launch: unexpected shapes (n_in %d, in0 %d, out %d, ws %zu); nothing launched\n", n_in, n_in > 0 ? in_sizes[0] : -1, out_size, ws_size);
            grid = -1; return;
        }
        int dev = 0, cus = 0, per_cu = 0;
        (void)hipGetDevice(&dev);
        (void)hipDeviceGetAttribute(&cus, hipDeviceAttributeMultiprocessorCount, dev);
        if (hipFuncSetAttribute((const void*)fwd_kernel, hipFuncAttributeMaxDynamicSharedMemorySize, LDS_BYTES) != hipSuccess) { fprintf(stderr, "kernel_launch: hipFuncSetAttribute failed\n"); grid = -1; return; }
        if (hipOccupancyMaxActiveBlocksPerMultiprocessor(&per_cu, (const void*)fwd_kernel, NTHREADS, LDS_BYTES) != hipSuccess || per_cu < 1) { fprintf(stderr, "kernel_launch: occupancy query failed (%d)\n", per_cu); (void)hipGetLastError(); per_cu = 1; }
        if (per_cu > 1) per_cu = 1;
        grid = cus * per_cu;
        if (grid <= 0) grid = 256;
    }
    if (grid < 0) return;
    if (hipMemsetAsync((char*)d_ws + OFF_BAR, 0, 16384, stream) != hipSuccess) { fprintf(stderr, "kernel_launch: hipMemsetAsync failed\n"); return; }
    Params p{};
    const float** pp = (const float**)&p;
    for (int i = 0; i < 22; ++i) pp[i] = (const float*)d_in[i];
    p.out = (float*)d_out; p.ws = (unsigned char*)d_ws;
#if MK_SPLIT
    for (int ph = 0; ph < N_PHASES; ++ph) {
        p.ph_lo = ph; p.ph_hi = ph + 1;
        void* args[] = {&p};
        hipError_t e = hipLaunchCooperativeKernel((const void*)fwd_kernel, dim3(grid), dim3(NTHREADS), args, LDS_BYTES, stream);
        if (e != hipSuccess) { fprintf(stderr, "kernel_launch: launch of phase %d failed: %s\n", ph, hipGetErrorString(e)); break; }
    }
#else
    p.ph_lo = 0; p.ph_hi = N_PHASES;
    void* args[] = {&p};
    hipError_t e = hipLaunchCooperativeKernel((const void*)fwd_kernel, dim3(grid), dim3(NTHREADS), args, LDS_BYTES, stream);
    if (e != hipSuccess) fprintf(stderr, "kernel_launch: cooperative launch failed: %s (grid %d)\n", hipGetErrorString(e), grid);
#endif
}
```

```cpp
#include <hip/hip_runtime.h>
#include <hip/hip_cooperative_groups.h>
#include <cstdio>
#include <cstdint>
namespace cg = cooperative_groups;

#ifndef MK_SPLIT
#define MK_SPLIT 0
#endif

#define DI __device__ __forceinline__
typedef unsigned short bf16_t;
typedef short bf16x8 __attribute__((ext_vector_type(8)));
typedef short s16x4 __attribute__((ext_vector_type(4)));
typedef float f32x4 __attribute__((ext_vector_type(4)));
typedef float f32x16 __attribute__((ext_vector_type(16)));
typedef unsigned u32x4 __attribute__((ext_vector_type(4)));
typedef unsigned u32x2 __attribute__((ext_vector_type(2)));
typedef __bf16 bf16x2_t __attribute__((ext_vector_type(2)));
typedef float f32x2_t __attribute__((ext_vector_type(2)));

#define MFMA32(a, b, c) __builtin_amdgcn_mfma_f32_32x32x16_bf16((a), (b), (c), 0, 0, 0)
#define MFMA16(a, b, c) __builtin_amdgcn_mfma_f32_16x16x32_bf16((a), (b), (c), 0, 0, 0)

constexpr int NB = 16, SEQ = 4096, DM = 1024, NTOK = NB * SEQ;
constexpr int NIN_PAD = 2944;
constexpr int NTHREADS = 512;
constexpr float LOG2E = 1.4426950408889634f;
constexpr float QSCALE = 0.125f * LOG2E;
constexpr float NEGB = -1e30f;
constexpr float RMS_EPS = 1e-6f;
constexpr int LDS_BYTES = 163840;

constexpr size_t MiB = 1u << 20;
constexpr size_t OFF_MOD = 0, OFF_TAB = 512 * 1024, OFF_PB = 520 * 1024, OFF_BAR = 768 * 1024;
constexpr size_t OFF_SK = 1 * MiB, OFF_W2T = 1 * MiB + 128 * 1024;
constexpr size_t OFF_W1T = 2 * MiB, OFF_WOUTT = 4 * MiB, OFF_WQT = 6 * MiB, OFF_WINT = 10 * MiB;
constexpr size_t OFF_HID = 16 * MiB, OFF_KCMP = 24 * MiB, OFF_VCMPT = 25 * MiB;
constexpr size_t OFF_U = 32 * MiB, OFF_V = 64 * MiB;
constexpr size_t OFF_US = 48 * MiB, OFF_VS = 80 * MiB;
constexpr size_t OFF_H = 96 * MiB;
constexpr size_t OFF_X1 = 224 * MiB;
constexpr size_t OFF_EID = 480 * MiB, OFF_GW = 512 * MiB;
constexpr size_t OFF_PROJ = 544 * MiB;
constexpr size_t OFF_QN = OFF_PROJ, OFF_KC = OFF_PROJ + 64 * MiB, OFF_VC = OFF_PROJ + 80 * MiB, OFF_KS = OFF_PROJ + 96 * MiB,
                 OFF_VST = OFF_PROJ + 112 * MiB, OFF_KW = OFF_PROJ + 128 * MiB, OFF_VWT = OFF_PROJ + 144 * MiB,
                 OFF_GATES = OFF_PROJ + 160 * MiB, OFF_DQ = OFF_PROJ + 168 * MiB, OFF_DK = OFF_PROJ + 232 * MiB,
                 OFF_DVT = OFF_PROJ + 296 * MiB;
constexpr size_t OFF_QP = OFF_PROJ;
constexpr size_t OFF_CO = 904 * MiB;
constexpr size_t OFF_HQ8 = 936 * MiB;
constexpr size_t OFF_HSC = 1000 * MiB;
constexpr size_t WS_NEED = 1001 * MiB;

struct Params {
    const float *x, *c, *rel_bias, *ada_w, *ada_b, *norm1_g, *norm2_g, *w_in, *w_out, *cmp_pos, *cmp_w1, *cmp_w2,
                *lam_q1, *lam_k1, *lam_q2, *lam_k2, *subln_g, *peer_wq, *peer_sub, *peer_u, *peer_v, *final_g;
    float* out;
    unsigned char* ws;
    int ph_lo, ph_hi;
};

DI unsigned pk2(float lo, float hi) { f32x2_t v = {lo, hi}; bf16x2_t b = __builtin_convertvector(v, bf16x2_t); return __builtin_bit_cast(unsigned, b); }
DI float bf_lo(unsigned w) { return __uint_as_float(w << 16); }
DI float bf_hi(unsigned w) { return __uint_as_float(w & 0xffff0000u); }
DI float wave_sum(float v) {
#pragma unroll
    for (int o = 1; o < 64; o <<= 1) v += __shfl_xor(v, o);
    return v;
}
DI float gelu_tanh(float x) {
    const float u = 0.7978845608028654f * (x + 0.044715f * x * x * x);
    const float e = __builtin_amdgcn_exp2f(-2.0f * LOG2E * u);
    const float th = (1.0f - e) / (1.0f + e);
    return 0.5f * x * (1.0f + th);
}
DI int ltid() { int t = threadIdx.x; asm volatile("" : "+v"(t)); return t; }
DI int crow(int reg, int h) { return (reg & 3) + 8 * (reg >> 2) + 4 * h; }
DI int t5_bucket(int d) {
    if (d < 16) return d;
    int b = 16;
    b += (d >= 19); b += (d >= 21); b += (d >= 24); b += (d >= 27); b += (d >= 31); b += (d >= 35); b += (d >= 40); b += (d >= 46);
    b += (d >= 52); b += (d >= 59); b += (d >= 67); b += (d >= 77); b += (d >= 87); b += (d >= 99); b += (d >= 113);
    return b;
}
DI int perm_in(int n) {
    if (n < 896) return n;
    if (n < 1024) return 2304 + (n - 896);
    if (n < 1152) return 896 + (n - 1024);
    if (n < 1280) return 2432 + (n - 1152);
    if (n < 1304) return 2048 + (n - 1280);
    if (n < 1816) return 1024 + (n - 1304);
    if (n < 2328) return 1536 + (n - 1816);
    return 2560 + (n - 2328);
}

DI void transpose_unit(char* smem, const float* __restrict__ W, int K, int N, bf16_t* __restrict__ Wt, int kb, int nb, int mode) {
    float* tile = (float*)smem;
    const int tid = ltid();
#pragma unroll
    for (int it = 0; it < 8; ++it) {
        const int i = (tid >> 6) + 8 * it, j = tid & 63, n = nb * 64 + j;
        tile[i * 65 + j] = (n < N) ? W[(size_t)(kb * 64 + i) * N + n] : 0.f;
    }
    __syncthreads();
    {
        const int j = tid >> 3, kc = tid & 7, n = nb * 64 + j;
        if (n < N) {
            const int np = mode == 1 ? perm_in(n) : n;
            u32x4 o;
            o.x = pk2(tile[(kc * 8 + 0) * 65 + j], tile[(kc * 8 + 1) * 65 + j]);
            o.y = pk2(tile[(kc * 8 + 2) * 65 + j], tile[(kc * 8 + 3) * 65 + j]);
            o.z = pk2(tile[(kc * 8 + 4) * 65 + j], tile[(kc * 8 + 5) * 65 + j]);
            o.w = pk2(tile[(kc * 8 + 6) * 65 + j], tile[(kc * 8 + 7) * 65 + j]);
            *(u32x4*)(Wt + (size_t)np * K + kb * 64 + kc * 8) = o;
        }
    }
    __syncthreads();
}

DI void mod_unit(char* smem, const Params& P, int u) {
    float* cond = (float*)smem;
    float* red = (float*)(smem + 65536);
    const int tid = ltid(), lane = tid & 63, wid = tid >> 6;
    for (int i = tid; i < NB * DM; i += NTHREADS) {
        const int b = i >> 10, k = i & 1023;
        const float cv = P.c[i];
        cond[k * 16 + b] = cv / (1.0f + __expf(-cv));
    }
    __syncthreads();
    const int col = u * 64 + lane;
    float acc[16];
#pragma unroll
    for (int b = 0; b < 16; ++b) acc[b] = 0.f;
    const float* wp = P.ada_w + (size_t)(wid * 128) * 6144 + col;
    for (int k0 = 0; k0 < 128; k0 += 16) {
        float wv[16];
#pragma unroll
        for (int i = 0; i < 16; ++i) wv[i] = wp[(size_t)(k0 + i) * 6144];
#pragma unroll
        for (int i = 0; i < 16; ++i) {
            const int k = wid * 128 + k0 + i;
            const float w = wv[i];
            const f32x4 c0 = *(const f32x4*)(cond + k * 16), c1 = *(const f32x4*)(cond + k * 16 + 4), c2 = *(const f32x4*)(cond + k * 16 + 8), c3 = *(const f32x4*)(cond + k * 16 + 12);
            acc[0] += w * c0.x; acc[1] += w * c0.y; acc[2] += w * c0.z; acc[3] += w * c0.w;
            acc[4] += w * c1.x; acc[5] += w * c1.y; acc[6] += w * c1.z; acc[7] += w * c1.w;
            acc[8] += w * c2.x; acc[9] += w * c2.y; acc[10] += w * c2.z; acc[11] += w * c2.w;
            acc[12] += w * c3.x; acc[13] += w * c3.y; acc[14] += w * c3.z; acc[15] += w * c3.w;
        }
    }
#pragma unroll
    for (int b = 0; b < 16; ++b) red[(wid * 16 + b) * 64 + lane] = acc[b];
    __syncthreads();
    float* mod = (float*)(P.ws + OFF_MOD);
    for (int o = tid; o < 16 * 64; o += NTHREADS) {
        const int b = o >> 6, c = o & 63;
        float t = P.ada_b[u * 64 + c];
#pragma unroll
        for (int w = 0; w < 8; ++w) t += red[(w * 16 + b) * 64 + c];
        mod[(size_t)b * 6144 + u * 64 + c] = t;
    }
    __syncthreads();
}

DI void misc_unit(const Params& P) {
    const int tid = ltid();
    float* tab = (float*)(P.ws + OFF_TAB);
    for (int i = tid; i < 12 * 128; i += NTHREADS) {
        const int hd = i >> 7, d = i & 127;
        tab[i] = (P.rel_bias[t5_bucket(d) * 12 + hd] - P.rel_bias[31 * 12 + hd]) * LOG2E;
    }
    bf16_t* sk = (bf16_t*)(P.ws + OFF_SK);
    for (int i = tid; i < 2 * 128 * 128 / 2; i += NTHREADS) ((unsigned*)sk)[i] = pk2(P.peer_sub[2 * i], P.peer_sub[2 * i + 1]);
    unsigned* wz = (unsigned*)((bf16_t*)(P.ws + OFF_WINT) + (size_t)2072 * 1024);
    for (int i = tid; i < 232 * 1024 / 2; i += NTHREADS) wz[i] = 0u;
    for (int kv = 0; kv < 2; ++kv) {
        unsigned* z2 = (unsigned*)((bf16_t*)(P.ws + OFF_W2T) + (size_t)(kv * 128 + 64) * 256);
        for (int i = tid; i < 64 * 256 / 2; i += NTHREADS) z2[i] = 0u;
    }
}

DI void pb_unit(char* smem, const Params& P, int u) {
    const int tid = ltid(), lane = tid & 63, c = lane & 15, ph = lane >> 4, kp = tid >> 6, o = u * 16 + c;
    const int kv = o >> 8, n = o & 255;
    const float* pos = P.cmp_pos + kv * 2048 + kp * 256 + ph;
    const float* w1 = P.cmp_w1 + (size_t)kv * 2048 * 256 + (size_t)(kp * 256 + ph) * 256 + n;
    float a = 0.f;
    for (int j0 = 0; j0 < 64; j0 += 16) {
        float wv[16];
#pragma unroll
        for (int i = 0; i < 16; ++i) wv[i] = w1[(size_t)(4 * (j0 + i)) * 256];
#pragma unroll
        for (int i = 0; i < 16; ++i) a += pos[4 * (j0 + i)] * wv[i];
    }
    a += __shfl_xor(a, 16);
    a += __shfl_xor(a, 32);
    float* red = (float*)smem;
    __syncthreads();
    if (lane < 16) red[kp * 16 + c] = a;
    __syncthreads();
    if (tid < 16) {
        float t = 0.f;
#pragma unroll
        for (int q = 0; q < 8; ++q) t += red[q * 16 + tid];
        ((float*)(P.ws + OFF_PB))[u * 16 + tid] = t;
    }
    __syncthreads();
}

template <int PART>
DI void phase_prologue(const Params& P, char* smem, int bidv, int Gv) {
    const int tid = ltid(), G = Gv, bid = bidv;
    if (PART != 0) {
        const int lane = tid & 63, wid = tid >> 6;
        for (int rw0 = (bid * 8 + wid) * 4; rw0 < 2 * 16384; rw0 += G * 8 * 4) {
            f32x4 v[4][4];
#pragma unroll
            for (int q = 0; q < 4; ++q) {
                const int rw = rw0 + q, tb = rw >> 14, e = rw & 16383;
                const float* src = (tb ? P.peer_v : P.peer_u) + (size_t)e * DM + 16 * lane;
#pragma unroll
                for (int j = 0; j < 4; ++j) v[q][j] = *(const f32x4*)(src + 4 * j);
            }
#pragma unroll
            for (int q = 0; q < 4; ++q) {
                const int rw = rw0 + q, tb = rw >> 14, e = rw & 16383;
                float am = 0.f;
#pragma unroll
                for (int j = 0; j < 4; ++j) am = fmaxf(am, fmaxf(fmaxf(fabsf(v[q][j].x), fabsf(v[q][j].y)), fmaxf(fabsf(v[q][j].z), fabsf(v[q][j].w))));
#pragma unroll
                for (int o = 1; o < 64; o <<= 1) am = fmaxf(am, __shfl_xor(am, o));
                const float sc = am > 0.f ? am * (1.0f / 127.0f) : 1.0f, inv = 1.0f / sc;
                u32x4 o4;
#pragma unroll
                for (int j = 0; j < 4; ++j) {
                    const int q0 = (int)rintf(v[q][j].x * inv) + 128, q1 = (int)rintf(v[q][j].y * inv) + 128, q2 = (int)rintf(v[q][j].z * inv) + 128, q3 = (int)rintf(v[q][j].w * inv) + 128;
                    const unsigned w = (unsigned)(q0 < 0 ? 0 : (q0 > 255 ? 255 : q0)) | ((unsigned)(q1 < 0 ? 0 : (q1 > 255 ? 255 : q1)) << 8) |
                                       ((unsigned)(q2 < 0 ? 0 : (q2 > 255 ? 255 : q2)) << 16) | ((unsigned)(q3 < 0 ? 0 : (q3 > 255 ? 255 : q3)) << 24);
                    if (j == 0) o4.x = w; else if (j == 1) o4.y = w; else if (j == 2) o4.z = w; else o4.w = w;
                }
                unsigned char* dst = P.ws + (tb ? OFF_V : OFF_U);
                o4.x ^= 0x80808080u; o4.y ^= 0x80808080u; o4.z ^= 0x80808080u; o4.w ^= 0x80808080u;
                *(u32x4*)(dst + (size_t)e * DM + 16 * lane) = o4;
                if (lane == 0) ((float*)(P.ws + (tb ? OFF_VS : OFF_US)))[e] = sc;
            }
        }
    }
    constexpr int U_MOD = 96, U_MISC = 1, U_PB = 32;
    constexpr int U_WIN = 16 * 45, U_WOUT = 16 * 16, U_WQ = 16 * 32, U_W1 = 2 * 32 * 4, U_W2 = 2 * 4 * 1;
    constexpr int U_TOT = U_MOD + U_MISC + U_PB + U_WIN + U_WOUT + U_WQ + U_W1 + U_W2;
    for (int u = bid; u < U_TOT; u += G) {
        int r = u;
        constexpr bool EARLY = PART != 1, LATE = PART != 0;
        if (r < U_MOD) { if (EARLY) mod_unit(smem, P, r); continue; } r -= U_MOD;
        if (r < U_MISC) { if (EARLY) misc_unit(P); continue; } r -= U_MISC;
        if (r < U_PB) { if (EARLY) pb_unit(smem, P, r); continue; } r -= U_PB;
        if (r < U_WIN) { if (EARLY) transpose_unit(smem, P.w_in, 1024, 2840, (bf16_t*)(P.ws + OFF_WINT), r / 45, r % 45, 1); continue; } r -= U_WIN;
        if (r < U_WOUT) { if (LATE) transpose_unit(smem, P.w_out, 1024, 1024, (bf16_t*)(P.ws + OFF_WOUTT), r / 16, r % 16, 0); continue; } r -= U_WOUT;
        if (r < U_WQ) { if (LATE) transpose_unit(smem, P.peer_wq, 1024, 2048, (bf16_t*)(P.ws + OFF_WQT), r / 32, r % 32, 0); continue; } r -= U_WQ;
        if (r < U_W1) { if (EARLY) { const int kv = r / 128, q = r % 128; transpose_unit(smem, P.cmp_w1 + (size_t)kv * 2048 * 256, 2048, 256, (bf16_t*)(P.ws + OFF_W1T) + (size_t)kv * 256 * 2048, q / 4, q % 4, 0); } continue; } r -= U_W1;
        if (EARLY) { const int kv = r / 4, q = r % 4; transpose_unit(smem, P.cmp_w2 + (size_t)kv * 256 * 64, 256, 64, (bf16_t*)(P.ws + OFF_W2T) + (size_t)kv * 128 * 256, q, 0, 0); }
    }
}

template <bool BF16IN>
DI void phase_normmod(const Params& P, const void* __restrict__ xin_, const float* __restrict__ gvec, int sh_idx, int sc_idx, bf16_t* __restrict__ outp,
                      int row0 = 0, int row1 = NTOK, int bi = blockIdx.x, int nb = gridDim.x) {
    const int tid = ltid(), lane = tid & 63, wid = tid >> 6;
    const float* mod = (const float*)(P.ws + OFF_MOD);
    const int gw = bi * 8 + wid, NGW = nb * 8;
    for (int row = row0 + gw; row < row1; row += NGW) {
        const int b = row >> 12;
        f32x4 v[4]; float ss = 0.f;
        if (BF16IN) {
            const u32x2* xr = (const u32x2*)((const bf16_t*)xin_ + (size_t)row * DM) + lane;
#pragma unroll
            for (int j = 0; j < 4; ++j) { const u32x2 w = xr[64 * j]; v[j] = (f32x4){bf_lo(w.x), bf_hi(w.x), bf_lo(w.y), bf_hi(w.y)}; }
        } else {
            const f32x4* xr = (const f32x4*)((const float*)xin_ + (size_t)row * DM) + lane;
#pragma unroll
            for (int j = 0; j < 4; ++j) v[j] = xr[64 * j];
        }
#pragma unroll
        for (int j = 0; j < 4; ++j) ss += (v[j].x * v[j].x + v[j].y * v[j].y) + (v[j].z * v[j].z + v[j].w * v[j].w);
        const float rstd = __builtin_amdgcn_rsqf(wave_sum(ss) * (1.0f / DM) + RMS_EPS);
        const float* shp = mod + (size_t)b * 6144 + sh_idx * 1024;
        const float* scp = mod + (size_t)b * 6144 + sc_idx * 1024;
        u32x2* o8 = (u32x2*)(outp + (size_t)row * DM) + lane;
        f32x4 av[4]; float am = 0.f;
#pragma unroll
        for (int j = 0; j < 4; ++j) {
            const int col = 4 * lane + 256 * j;
            const f32x4 g = *(const f32x4*)(gvec + col), sc = *(const f32x4*)(scp + col), sh = *(const f32x4*)(shp + col);
            const float a0 = v[j].x * rstd * g.x * (1.f + sc.x) + sh.x, a1 = v[j].y * rstd * g.y * (1.f + sc.y) + sh.y;
            const float a2 = v[j].z * rstd * g.z * (1.f + sc.z) + sh.z, a3 = v[j].w * rstd * g.w * (1.f + sc.w) + sh.w;
            u32x2 w; w.x = pk2(a0, a1); w.y = pk2(a2, a3);
            o8[64 * j] = w;
            if (BF16IN) { av[j] = (f32x4){a0, a1, a2, a3}; am = fmaxf(am, fmaxf(fmaxf(fabsf(a0), fabsf(a1)), fmaxf(fabsf(a2), fabsf(a3)))); }
        }
        if (BF16IN) {
#pragma unroll
            for (int o = 1; o < 64; o <<= 1) am = fmaxf(am, __shfl_xor(am, o));
            const float qs = am > 0.f ? 127.0f / am : 0.f;
            unsigned* q8 = (unsigned*)(P.ws + OFF_HQ8 + (size_t)row * DM) + lane;
#pragma unroll
            for (int j = 0; j < 4; ++j) {
                const int q0 = (int)rintf(av[j].x * qs), q1 = (int)rintf(av[j].y * qs), q2 = (int)rintf(av[j].z * qs), q3 = (int)rintf(av[j].w * qs);
                q8[64 * j] = (unsigned)(q0 & 255) | ((unsigned)(q1 & 255) << 8) | ((unsigned)(q2 & 255) << 16) | ((unsigned)(q3 & 255) << 24);
            }
            if (lane == 0) ((float*)(P.ws + OFF_HSC))[row] = am * (1.0f / 127.0f);
        }
    }
}

constexpr int G_STAGE = 49152;
struct ARowMajor {
    const bf16_t* A; int lda;
    DI const bf16_t* operator()(int m, int kt) const { return A + (size_t)m * lda + kt * 64; }
};
struct ACmp {
    const bf16_t* src;
    DI const bf16_t* operator()(int m, int kt) const {
        const int bg = m >> 8; int c = m & 255; c = c > 254 ? 254 : c;
        return src + ((size_t)((bg >> 1) * SEQ + 16 * c + kt)) * 128 + (bg & 1) * 64;
    }
};

template <bool TRANS, class AF, class Epi>
DI void gemm_tile(char* smem, const AF& af, const bf16_t* __restrict__ Bt, int ldb, int m0, int n0, int nk, const Epi& epi) {
    const int tid = ltid(), lane = tid & 63, wid = tid >> 6, wr = wid >> 1, wc = wid & 1, fr = lane & 15, fq = lane >> 4;
    const int lrow = tid >> 3, lc = tid & 7;
    const int ldsoff = lrow * 128 + ((lc ^ ((tid >> 4) & 7)) << 4);
    const bf16_t* ap[4]; const bf16_t* bp[2];
#pragma unroll
    for (int i = 0; i < 4; ++i) ap[i] = af(m0 + lrow + 64 * i, 0) + lc * 8;
#pragma unroll
    for (int i = 0; i < 2; ++i) bp[i] = Bt + (size_t)(n0 + lrow + 64 * i) * ldb + lc * 8;
    const int astep = (int)(af(m0, 1) - af(m0, 0));
    f32x4 acc[4][4];
#pragma unroll
    for (int i = 0; i < 4; ++i)
#pragma unroll
        for (int j = 0; j < 4; ++j) acc[i][j] = (f32x4){0.f, 0.f, 0.f, 0.f};
    u32x4 ra[4], rb[2];
#pragma unroll
    for (int i = 0; i < 4; ++i) ra[i] = *(const u32x4*)(ap[i]);
#pragma unroll
    for (int i = 0; i < 2; ++i) rb[i] = *(const u32x4*)(bp[i]);
    __syncthreads();
#pragma unroll
    for (int i = 0; i < 4; ++i) *(u32x4*)(smem + ldsoff + i * 8192) = ra[i];
#pragma unroll
    for (int i = 0; i < 2; ++i) *(u32x4*)(smem + 32768 + ldsoff + i * 8192) = rb[i];
    __syncthreads();
    const int sws = fr >> 1;
    const int aoff = (64 * wr + fr) * 128, boff = 32768 + (64 * wc + fr) * 128;
    for (int kt = 0; kt < nk; ++kt) {
        const int st = kt & 1;
        if (kt + 1 < nk) {
#pragma unroll
            for (int i = 0; i < 4; ++i) ra[i] = *(const u32x4*)(ap[i] + (size_t)(kt + 1) * astep);
#pragma unroll
            for (int i = 0; i < 2; ++i) rb[i] = *(const u32x4*)(bp[i] + (kt + 1) * 64);
        }
        const char* sb = smem + st * G_STAGE;
#pragma unroll
        for (int kk = 0; kk < 2; ++kk) {
            const int cho = ((kk * 4 + fq) ^ sws) << 4;
            bf16x8 afr[4], bfr[4];
#pragma unroll
            for (int i = 0; i < 4; ++i) afr[i] = *(const bf16x8*)(sb + aoff + i * 2048 + cho);
#pragma unroll
            for (int j = 0; j < 4; ++j) bfr[j] = *(const bf16x8*)(sb + boff + j * 2048 + cho);
#pragma unroll
            for (int i = 0; i < 4; ++i)
#pragma unroll
                for (int j = 0; j < 4; ++j)
                    acc[i][j] = TRANS ? MFMA16(afr[i], bfr[j], acc[i][j]) : MFMA16(bfr[j], afr[i], acc[i][j]);
        }
        if (kt + 1 < nk) {
            char* sn = smem + (st ^ 1) * G_STAGE;
#pragma unroll
            for (int i = 0; i < 4; ++i) *(u32x4*)(sn + ldsoff + i * 8192) = ra[i];
#pragma unroll
            for (int i = 0; i < 2; ++i) *(u32x4*)(sn + 32768 + ldsoff + i * 8192) = rb[i];
        }
        __syncthreads();
    }
#pragma unroll
    for (int i = 0; i < 4; ++i)
#pragma unroll
        for (int j = 0; j < 4; ++j) {
            if (TRANS) epi.tr(m0 + 64 * wr + 16 * i + 4 * fq, n0 + 64 * wc + 16 * j + fr, acc[i][j]);
            else epi.nt(m0 + 64 * wr + 16 * i + fr, n0 + 64 * wc + 16 * j + 4 * fq, acc[i][j]);
        }
}

DI void st_bf8(bf16_t* p, f32x4 a, f32x4 b, float s) { u32x4 w; w.x = pk2(a.x * s, a.y * s); w.y = pk2(a.z * s, a.w * s); w.z = pk2(b.x * s, b.y * s); w.w = pk2(b.z * s, b.w * s); *(u32x4*)p = w; }
DI void st_bf4(bf16_t* p, f32x4 v, float s) { u32x2 w; w.x = pk2(v.x * s, v.y * s); w.y = pk2(v.z * s, v.w * s); *(u32x2*)p = w; }

DI size_t qblk(size_t tok, int col8) { return (((tok >> 5) * 64 + (size_t)col8) * 32 + (tok & 31)) * 8; }
struct EpiInProj {
    unsigned char* ws;
    DI void nt8(int m, int n, f32x4 v0, f32x4 v1) const {
        if (n < 512) st_bf8((bf16_t*)(ws + OFF_QN) + qblk((size_t)m, n >> 3), v0, v1, QSCALE);
        else if (n < 640) st_bf8((bf16_t*)(ws + OFF_KC) + (size_t)m * 128 + (n - 512), v0, v1, 1.f);
        else if (n < 768) st_bf8((bf16_t*)(ws + OFF_VC) + (size_t)m * 128 + (n - 640), v0, v1, 1.f);
        else if (n < 896) st_bf8((bf16_t*)(ws + OFF_KS) + (size_t)m * 128 + (n - 768), v0, v1, 1.f);
        else if (n < 1024) st_bf8((bf16_t*)(ws + OFF_KW) + (size_t)m * 128 + (n - 896), v0, v1, 1.f);
        else if (n < 1536) st_bf8((bf16_t*)(ws + OFF_DQ) + qblk((size_t)m, (n - 1024) >> 3), v0, v1, QSCALE);
        else if (n < 2048) st_bf8((bf16_t*)(ws + OFF_DK) + (size_t)m * 512 + (n - 1536), v0, v1, 1.f);
        else if (n < 2072) {
            float* gp = (float*)(ws + OFF_GATES) + (size_t)m * 24 + (n - 2048);
            f32x4 o0, o1;
            o0.x = 1.f / (1.f + __expf(-v0.x)); o0.y = 1.f / (1.f + __expf(-v0.y)); o0.z = 1.f / (1.f + __expf(-v0.z)); o0.w = 1.f / (1.f + __expf(-v0.w));
            o1.x = 1.f / (1.f + __expf(-v1.x)); o1.y = 1.f / (1.f + __expf(-v1.y)); o1.z = 1.f / (1.f + __expf(-v1.z)); o1.w = 1.f / (1.f + __expf(-v1.w));
            *(f32x4*)gp = o0; *(f32x4*)(gp + 4) = o1;
        }
    }
};
struct EpiInProjT {
    unsigned char* ws;
    DI void nt8(int vr, int t, f32x4 v0, f32x4 v1) const {
        const int b = t >> 12, sq = t & 4095;
        bf16_t* dst;
        if (vr < 128) dst = (bf16_t*)(ws + OFF_VST) + ((size_t)(b * 128 + vr)) * SEQ + sq;
        else if (vr < 256) dst = (bf16_t*)(ws + OFF_VWT) + ((size_t)(b * 128 + (vr - 128))) * SEQ + sq;
        else dst = (bf16_t*)(ws + OFF_DVT) + ((size_t)(b * 512 + (vr - 256))) * SEQ + sq;
        st_bf8(dst, v0, v1, 1.f);
    }
};
DI bool inproj_tile_is_trans(int) { return false; }

struct EpiCmp1 {
    bf16_t* hid; const float* pb;
    DI void nt(int m, int n, f32x4 v) const {
        const f32x4 p = *(const f32x4*)(pb + n);
        u32x2 w; w.x = pk2(gelu_tanh(v.x + p.x), gelu_tanh(v.y + p.y)); w.y = pk2(gelu_tanh(v.z + p.z), gelu_tanh(v.w + p.w));
        *(u32x2*)(hid + (size_t)m * 256 + n) = w;
    }
    DI void tr(int, int, f32x4) const {}
};
struct EpiCmp2 {
    bf16_t* kc; bf16_t* vt;
    DI void nt(int m, int n, f32x4 v) const { if (n < 64) st_bf4(kc + (size_t)m * 64 + n, v, 1.f); }
    DI void tr(int m, int n, f32x4 v) const { if (n < 64) st_bf4(vt + ((size_t)((m >> 8) * 64 + n)) * 256 + (m & 255), v, 1.f); }
};
struct EpiOutProj {
    const float* x; const float* mod; bf16_t* x1;
    DI void nt(int m, int n, f32x4 v) const {
        const int b = m >> 12;
        const f32x4 g = *(const f32x4*)(mod + (size_t)b * 6144 + 2 * 1024 + n);
        const f32x4 xv = *(const f32x4*)(x + (size_t)m * DM + n);
        f32x4 o; o.x = xv.x + g.x * v.x; o.y = xv.y + g.y * v.y; o.z = xv.z + g.z * v.z; o.w = xv.w + g.w * v.w;
        st_bf4(x1 + (size_t)m * DM + n, o, 1.f);
    }
    DI void nt8(int m, int n, f32x4 v0, f32x4 v1) const {
        const int b = m >> 12;
        const float* gp = mod + (size_t)b * 6144 + 2 * 1024 + n; const float* xp = x + (size_t)m * DM + n;
        const f32x4 g0 = *(const f32x4*)gp, g1 = *(const f32x4*)(gp + 4), x0 = *(const f32x4*)xp, xq = *(const f32x4*)(xp + 4);
        f32x4 o0, o1;
        o0.x = x0.x + g0.x * v0.x; o0.y = x0.y + g0.y * v0.y; o0.z = x0.z + g0.z * v0.z; o0.w = x0.w + g0.w * v0.w;
        o1.x = xq.x + g1.x * v1.x; o1.y = xq.y + g1.y * v1.y; o1.z = xq.z + g1.z * v1.z; o1.w = xq.w + g1.w * v1.w;
        st_bf8(x1 + (size_t)m * DM + n, o0, o1, 1.f);
    }
    DI void tr(int, int, f32x4) const {}
};
struct EpiWq {
    bf16_t* qp;
    DI void nt8(int m, int n, f32x4 v0, f32x4 v1) const {
        const int d = n & 127;
        bf16_t* dst = qp + ((size_t)(m >> 5) * 16 + (n >> 7)) * 4096 + (size_t)((d >> 3) * 32 + (m & 31)) * 8;
        st_bf8(dst, v0, v1, 1.f);
    }
    DI void nt(int, int, f32x4) const {}
    DI void tr(int, int, f32x4) const {}
};

namespace pg8 {
#define PG8_LAS __attribute__((address_space(3)))
typedef unsigned short bf16_t;
typedef short bf16x8 __attribute__((ext_vector_type(8)));
typedef float f32x4 __attribute__((ext_vector_type(4)));
typedef unsigned u32x4 __attribute__((ext_vector_type(4)));
constexpr int BM = 256, BK = 64, HALF = 128, HTB = HALF * BK * 2  , STAGE_BYTES = 8 * HTB, NXCD = 8, WGM = 8;

__host__ __device__ __forceinline__ int lds_byte(int r, int c) { const int st = (r >> 4) * 2 + (c >> 5), rr = r & 15, cc = c & 31, ob = rr * 64 + cc * 2; return st * 1024 + (ob ^ (((ob >> 9) & 1) << 5)); }
__host__ __device__ __forceinline__ void stage_rc(int b, int& R, int& C) { const int st = b / 1024, sb = b % 1024, swz = sb ^ (((sb >> 9) & 1) << 5); R = (st >> 1) * 16 + swz / 64; C = (st & 1) * 32 + (swz % 64) / 2; }
__host__ __device__ __forceinline__ int perm32(int rho) { const int n = rho >> 4, i = rho & 15; return 8 * (i >> 2) + 4 * n + (i & 3); }

struct Unit { int pm, pn; };
struct Gemm { const bf16_t* A; const bf16_t* Bt; int M, N, K; };

struct StaticOrder {
    int nM, nN, nwg, G, c;
    __host__ __device__ void init(int M, int N, int G_, int c_) { nM = M / BM; nN = N / BM; nwg = nM * nN; G = G_; c = c_; }
    __host__ __device__ bool next(int i, Unit& u) const {
        const long L = (long)i * G + c; if (L >= nwg) return false;
        int wgid = (int)L; { const int q = nwg / NXCD, r = nwg % NXCD, xcd = wgid % NXCD, off = wgid / NXCD; wgid = (xcd < r ? xcd * (q + 1) : r * (q + 1) + (xcd - r) * q) + off; }
        const int nig = WGM * nN, gid = wgid / nig, fm = gid * WGM, gsz = (nM - fm) < WGM ? (nM - fm) : WGM;
        u.pm = fm + ((wgid % nig) % gsz); u.pn = (wgid % nig) / gsz; return true;
    }
    __device__ __forceinline__ void a_ready(const Unit&) const {}
    __device__ __forceinline__ void done(const Unit&) const {}
};


template <class Epi, class Sched, bool ALIGN_EPI = false, bool SP2 = false>
__device__ __forceinline__ void gemm_phase(PG8_LAS unsigned char* lds, const Gemm g, const Sched& S, const Epi& E) {
    const int tid = ltid(), wid = __builtin_amdgcn_readfirstlane(tid >> 6), lane = tid & 63, wr = wid >> 2, wc = wid & 3, fr = lane & 15, fq = lane >> 4;
    const int K = g.K, nt = K / BK;
    unsigned voffA[2], voffB[2];
#pragma unroll
    for (int i = 0; i < 2; ++i) { int R, C; stage_rc(tid * 16 + i * 8192, R, C); const int Rb = Epi::PERM ? ((R & ~31) + perm32(R & 31)) : R;
        voffA[i] = (unsigned)(R * K + C) * 2u; voffB[i] = (unsigned)(Rb * K + C) * 2u; }
    const size_t kstep = (size_t)(BK * 2);
    const size_t hstep = (size_t)HALF * K * 2;
    const size_t tstep = 2 * hstep;
    const unsigned ldsw = (unsigned)wid * 1024u;
    const int aoff = lds_byte(wr * 64 + fr, fq * 8), boff = lds_byte(wc * 32 + fr, fq * 8);
#define PG8_SA(b, h) (((b) * 2 + (h)) * HTB)
#define PG8_SB(b, h) ((4 + (b) * 2 + (h)) * HTB)
#define PG8_STAGE(bufoff, gbase, voff) do { _Pragma("unroll") for (int _i = 0; _i < 2; ++_i) \
        __builtin_amdgcn_global_load_lds((const unsigned*)((const char*)(gbase) + (voff)[_i]), (PG8_LAS unsigned*)(lds + (bufoff) + ldsw + _i * 8192), 16, 0, 0); } while (0)
#define PG8_LDA(dst, b, h) do { _Pragma("unroll") for (int m = 0; m < 4; ++m) _Pragma("unroll") for (int k = 0; k < 2; ++k) dst[m][k] = *(const PG8_LAS bf16x8*)(lds + PG8_SA(b, h) + aoff + m * 2048 + k * 1024); } while (0)
#define PG8_LDB(dst, b, h) do { _Pragma("unroll") for (int n = 0; n < 2; ++n) _Pragma("unroll") for (int k = 0; k < 2; ++k) dst[n][k] = *(const PG8_LAS bf16x8*)(lds + PG8_SB(b, h) + boff + n * 2048 + k * 1024); } while (0)
#define PG8_MMA(ai, bj, At, Bt) do { __builtin_amdgcn_s_setprio(1); _Pragma("unroll") for (int m = 0; m < 4; ++m) _Pragma("unroll") for (int n = 0; n < 2; ++n) _Pragma("unroll") for (int k = 0; k < 2; ++k) \
        acc[ai][bj][m][n] = __builtin_amdgcn_mfma_f32_16x16x32_bf16(Bt[n][k], At[m][k], acc[ai][bj][m][n], 0, 0, 0); __builtin_amdgcn_s_setprio(0); } while (0)
#define PG8_WAIT_V(n) asm volatile("s_waitcnt vmcnt(" #n ")" ::: "memory")
#define PG8_WAIT_L(n) asm volatile("s_waitcnt lgkmcnt(" #n ")" ::: "memory")
#define PG8_BAR __builtin_amdgcn_s_barrier()
#define PG8_SCHED __builtin_amdgcn_sched_barrier(0)
    Unit cur, nxt; int ui = 0;
    if (!S.next(0, cur)) return;
    f32x4 acc[2][2][4][2];
#pragma unroll
    for (int a = 0; a < 2; ++a)
#pragma unroll
        for (int b = 0; b < 2; ++b)
#pragma unroll
            for (int m = 0; m < 4; ++m)
#pragma unroll
                for (int n = 0; n < 2; ++n) acc[a][b][m][n] = (f32x4){0.f, 0.f, 0.f, 0.f};
    bf16x8 At[4][2], B0[2][2], B1[2][2];
    const char* cA = (const char*)g.A + (size_t)cur.pm * tstep; const char* cB = (const char*)g.Bt + (size_t)cur.pn * tstep;
    S.a_ready(cur);
    if constexpr (SP2) {
        PG8_STAGE(PG8_SB(0, 0), cB, voffB); PG8_STAGE(PG8_SB(0, 1), cB + hstep, voffB); PG8_STAGE(PG8_SA(0, 0), cA, voffA); PG8_STAGE(PG8_SA(0, 1), cA + hstep, voffA);
        if (wr == 1) PG8_BAR;
        PG8_WAIT_V(2); PG8_BAR;
        PG8_STAGE(PG8_SB(1, 0), cB + kstep, voffB); PG8_STAGE(PG8_SA(1, 0), cA + kstep, voffA); PG8_STAGE(PG8_SB(1, 1), cB + hstep + kstep, voffB);
        PG8_WAIT_V(6); PG8_BAR;
    } else {
        PG8_STAGE(PG8_SB(0, 0), cB, voffB); PG8_STAGE(PG8_SA(0, 0), cA, voffA); PG8_STAGE(PG8_SB(0, 1), cB + hstep, voffB); PG8_STAGE(PG8_SA(0, 1), cA + hstep, voffA);
        if (wr == 1) PG8_BAR;
        PG8_WAIT_V(4); PG8_BAR;
        PG8_STAGE(PG8_SB(1, 0), cB + kstep, voffB); PG8_STAGE(PG8_SA(1, 0), cA + kstep, voffA); PG8_STAGE(PG8_SB(1, 1), cB + hstep + kstep, voffB);
        PG8_WAIT_V(6); PG8_BAR;
    }
    for (;;) {
        const bool has_next = S.next(ui + 1, nxt);
        const char* nA = has_next ? (const char*)g.A + (size_t)nxt.pm * tstep : cA; const char* nB = has_next ? (const char*)g.Bt + (size_t)nxt.pn * tstep : cB;
        for (int t = 0; t < nt; t += 2) {
            const bool last = (t == nt - 2);
            const char* a1 = cA + (size_t)(t + 1) * kstep;
            const char* a2 = last ? nA : cA + (size_t)(t + 2) * kstep; const char* b2 = last ? nB : cB + (size_t)(t + 2) * kstep;
            const char* a3 = a2 + kstep; const char* b3 = b2 + kstep;
            if (last && has_next) S.a_ready(nxt);
            if constexpr (SP2) {
            PG8_LDB(B0, 0, 0); PG8_LDB(B1, 0, 1); PG8_SCHED; PG8_LDA(At, 0, 0); PG8_STAGE(PG8_SA(1, 1), a1 + hstep, voffA);
            PG8_WAIT_V(8); PG8_WAIT_L(0); PG8_BAR; PG8_MMA(0, 0, At, B0); PG8_MMA(0, 1, At, B1); PG8_BAR; PG8_SCHED;
            PG8_LDA(At, 0, 1); PG8_STAGE(PG8_SB(0, 0), b2, voffB); PG8_STAGE(PG8_SB(0, 1), b2 + hstep, voffB); PG8_STAGE(PG8_SA(0, 0), a2, voffA);
            PG8_WAIT_V(8); PG8_WAIT_L(0); PG8_BAR; PG8_MMA(1, 0, At, B0); PG8_MMA(1, 1, At, B1); PG8_BAR; PG8_SCHED;
            PG8_LDB(B0, 1, 0); PG8_LDB(B1, 1, 1); PG8_SCHED; PG8_LDA(At, 1, 0); PG8_STAGE(PG8_SA(0, 1), a2 + hstep, voffA);
            PG8_WAIT_V(8); PG8_WAIT_L(0); PG8_BAR; PG8_MMA(0, 0, At, B0); PG8_MMA(0, 1, At, B1); PG8_BAR; PG8_SCHED;
            PG8_LDA(At, 1, 1); PG8_STAGE(PG8_SB(1, 0), b3, voffB); PG8_STAGE(PG8_SB(1, 1), b3 + hstep, voffB); PG8_STAGE(PG8_SA(1, 0), a3, voffA);
            PG8_WAIT_V(8); PG8_WAIT_L(0); PG8_BAR; PG8_MMA(1, 0, At, B0); PG8_MMA(1, 1, At, B1); PG8_BAR; PG8_SCHED;
            } else {
            PG8_LDB(B0, 0, 0); PG8_SCHED; PG8_LDA(At, 0, 0); PG8_STAGE(PG8_SA(1, 1), a1 + hstep, voffA);
            PG8_WAIT_L(8); PG8_BAR; PG8_WAIT_L(0); PG8_MMA(0, 0, At, B0); PG8_BAR; PG8_SCHED;
            PG8_LDB(B1, 0, 1); PG8_STAGE(PG8_SB(0, 0), b2, voffB);
            PG8_BAR; PG8_WAIT_L(0); PG8_MMA(0, 1, At, B1); PG8_BAR;
            PG8_LDA(At, 0, 1); PG8_STAGE(PG8_SA(0, 0), a2, voffA);
            PG8_BAR; PG8_WAIT_L(0); PG8_MMA(1, 0, At, B0); PG8_BAR; PG8_SCHED;
            PG8_STAGE(PG8_SB(0, 1), b2 + hstep, voffB);
            PG8_WAIT_V(6); PG8_BAR; PG8_MMA(1, 1, At, B1); PG8_BAR;
            PG8_LDB(B0, 1, 0); PG8_SCHED; PG8_LDA(At, 1, 0); PG8_STAGE(PG8_SA(0, 1), a2 + hstep, voffA);
            PG8_WAIT_L(8); PG8_BAR; PG8_WAIT_L(0); PG8_MMA(0, 0, At, B0); PG8_BAR; PG8_SCHED;
            PG8_LDB(B1, 1, 1); PG8_STAGE(PG8_SB(1, 0), b3, voffB);
            PG8_BAR; PG8_WAIT_L(0); PG8_MMA(0, 1, At, B1); PG8_BAR;
            PG8_LDA(At, 1, 1); PG8_STAGE(PG8_SA(1, 0), a3, voffA);
            PG8_BAR; PG8_WAIT_L(0); PG8_MMA(1, 0, At, B0); PG8_BAR; PG8_SCHED;
            PG8_STAGE(PG8_SB(1, 1), b3 + hstep, voffB);
            PG8_WAIT_V(6); PG8_BAR; PG8_MMA(1, 1, At, B1); PG8_BAR;
            }
        }
        if constexpr (ALIGN_EPI) { if (wr == 0) PG8_BAR; }
        if constexpr (!Epi::AFTER_DRAIN) { E(acc, cur, wr, wc, fr, fq); S.done(cur); }
        if (!has_next) break;
#pragma unroll
        for (int a = 0; a < 2; ++a)
#pragma unroll
            for (int b = 0; b < 2; ++b)
#pragma unroll
                for (int m = 0; m < 4; ++m)
#pragma unroll
                    for (int n = 0; n < 2; ++n) acc[a][b][m][n] = (f32x4){0.f, 0.f, 0.f, 0.f};
        cur = nxt; cA = nA; cB = nB; ++ui;
        if constexpr (ALIGN_EPI) { if (wr == 1) PG8_BAR; }
    }
    PG8_WAIT_V(0);
    if constexpr (!ALIGN_EPI) { if (wr == 0) PG8_BAR; }
    PG8_BAR;
    if constexpr (Epi::AFTER_DRAIN) { E.fused(acc, cur, wr, wc, fr, fq, lds, wid, lane); S.done(cur); }
#undef PG8_SA
#undef PG8_SB
#undef PG8_STAGE
#undef PG8_LDA
#undef PG8_LDB
#undef PG8_MMA
#undef PG8_WAIT_V
#undef PG8_WAIT_L
#undef PG8_BAR
#undef PG8_SCHED
}
}


template <class F> struct EpiPg8 {
    static constexpr bool PERM = true, AFTER_DRAIN = false;
    F f;
    DI void operator()(const pg8::f32x4 (&acc)[2][2][4][2], const pg8::Unit& u, int wr, int wc, int fr, int fq) const {
#pragma unroll
        for (int ai = 0; ai < 2; ++ai)
#pragma unroll
            for (int m = 0; m < 4; ++m) {
                const int row = u.pm * 256 + 128 * ai + 64 * wr + 16 * m + fr;
#pragma unroll
                for (int bj = 0; bj < 2; ++bj) f.nt8(row, u.pn * 256 + 128 * bj + 32 * wc + 8 * fq, acc[ai][bj][m][0], acc[ai][bj][m][1]);
            }
    }
};

constexpr int VT_PITCH = 128;
DI int kperm(int rho) { return (rho & ~12) | ((rho & 4) << 1) | ((rho & 8) >> 1); }
DI int kidx(int reg, int h) { return (reg & 3) + 4 * ((reg >> 2) & 1) + 8 * h + 16 * (reg >> 3); }
#define LAS3 __attribute__((address_space(3)))
DI void glds16(const void* gsrc, char* lds_wave_base) { __builtin_amdgcn_global_load_lds((const unsigned*)gsrc, (LAS3 unsigned*)lds_wave_base, 16, 0, 0); }
constexpr float RESCALE_THR = 8.0f;

DI unsigned lds_addr(const char* p) { return (unsigned)(size_t)(LAS3 const char*)p; }
template <int OFF> DI bf16x8 ds128(unsigned a) { bf16x8 v; asm volatile("ds_read_b128 %0, %1 offset:%2" : "=v"(v) : "v"(a), "n"(OFF)); return v; }
#define MFMA_FENCE __builtin_amdgcn_sched_barrier(0)
#define LGKM_WAIT1(n, a) asm volatile("s_waitcnt lgkmcnt(" #n ")" : "+v"(a))
#define LGKM_WAIT2(n, a, b) asm volatile("s_waitcnt lgkmcnt(" #n ")" : "+v"(a), "+v"(b))
DI void qk_tile(const char* Ks, const bf16x8 (&qf)[4], int r, int h, const f32x16& cinit, f32x16& s0, f32x16& s1) {
    const int sw = (r >> 1) & 7;
    const unsigned kb = lds_addr(Ks) + r * 128;
    bf16x8 k0[4], k1[4];
#pragma unroll
    for (int ks = 0; ks < 4; ++ks) {
        const unsigned ka = kb + (((2 * ks + h) ^ sw) << 4);
        k0[ks] = ds128<0>(ka);
        k1[ks] = ds128<4096>(ka);
    }
    LGKM_WAIT2(6, k0[0], k1[0]);
    s0 = MFMA32(k0[0], qf[0], cinit); s1 = MFMA32(k1[0], qf[0], cinit);
    MFMA_FENCE;
    LGKM_WAIT2(4, k0[1], k1[1]);
    s0 = MFMA32(k0[1], qf[1], s0); s1 = MFMA32(k1[1], qf[1], s1);
    MFMA_FENCE;
    LGKM_WAIT2(2, k0[2], k1[2]);
    s0 = MFMA32(k0[2], qf[2], s0); s1 = MFMA32(k1[2], qf[2], s1);
    MFMA_FENCE;
    LGKM_WAIT2(0, k0[3], k1[3]);
    s0 = MFMA32(k0[3], qf[3], s0); s1 = MFMA32(k1[3], qf[3], s1);
    asm volatile("s_nop 15\n\ts_nop 7" : "+v"(s0), "+v"(s1));
}
DI void v_prefetch(const char* Vs, int r, int h, bf16x8 (&vf0)[4]) {
    const int sw = (r >> 1) & 7;
    const unsigned vb = lds_addr(Vs) + r * VT_PITCH;
#pragma unroll
    for (int st = 0; st < 4; ++st) vf0[st] = ds128<0>(vb + (((2 * st + h) ^ sw) << 4));
}
template <int NDT, int DT>
DI void pv_steps(const unsigned (&va)[4], bf16x8 (&cur)[4], const bf16x8 (&pf)[4], f32x16 (&o)[NDT]) {
    bf16x8 nxt[4];
    if constexpr (DT + 1 < NDT) {
#pragma unroll
        for (int st = 0; st < 4; ++st) nxt[st] = ds128<32 * VT_PITCH * (DT + 1)>(va[st]);
        LGKM_WAIT1(7, cur[0]); o[DT] = MFMA32(cur[0], pf[0], o[DT]);
        LGKM_WAIT1(6, cur[1]); o[DT] = MFMA32(cur[1], pf[1], o[DT]);
        LGKM_WAIT1(5, cur[2]); o[DT] = MFMA32(cur[2], pf[2], o[DT]);
        LGKM_WAIT1(4, cur[3]); o[DT] = MFMA32(cur[3], pf[3], o[DT]);
        MFMA_FENCE;
        pv_steps<NDT, DT + 1>(va, nxt, pf, o);
    } else {
        LGKM_WAIT1(3, cur[0]); o[DT] = MFMA32(cur[0], pf[0], o[DT]);
        LGKM_WAIT1(2, cur[1]); o[DT] = MFMA32(cur[1], pf[1], o[DT]);
        LGKM_WAIT1(1, cur[2]); o[DT] = MFMA32(cur[2], pf[2], o[DT]);
        LGKM_WAIT1(0, cur[3]); o[DT] = MFMA32(cur[3], pf[3], o[DT]);
    }
}
template <int NDT>
DI void pv_tile(const char* Vs, bf16x8 (&vf0)[4], const bf16x8 (&pf)[4], int r, int h, f32x16 (&o)[NDT]) {
    const int sw = (r >> 1) & 7;
    const unsigned vb = lds_addr(Vs) + r * VT_PITCH;
    unsigned va[4];
#pragma unroll
    for (int st = 0; st < 4; ++st) va[st] = vb + (((2 * st + h) ^ sw) << 4);
    pv_steps<NDT, 0>(va, vf0, pf, o);
}
DI void pack_p(const f32x16& p0, const f32x16& p1, bf16x8 (&pf)[4]) {
#pragma unroll
    for (int s = 0; s < 2; ++s) {
        u32x4 a, b;
        a.x = pk2(p0[8 * s + 0], p0[8 * s + 1]); a.y = pk2(p0[8 * s + 2], p0[8 * s + 3]); a.z = pk2(p0[8 * s + 4], p0[8 * s + 5]); a.w = pk2(p0[8 * s + 6], p0[8 * s + 7]);
        b.x = pk2(p1[8 * s + 0], p1[8 * s + 1]); b.y = pk2(p1[8 * s + 2], p1[8 * s + 3]); b.z = pk2(p1[8 * s + 4], p1[8 * s + 5]); b.w = pk2(p1[8 * s + 6], p1[8 * s + 7]);
        pf[s] = __builtin_bit_cast(bf16x8, a);
        pf[2 + s] = __builtin_bit_cast(bf16x8, b);
    }
}
template <int MODE>
DI void mask_tile(f32x16& s0, f32x16& s1, int h, int tq, int stride, int dmax, bool lane_ok, const float* tab) {
    if (MODE == 1) {
        if (!lane_ok) {
#pragma unroll
            for (int i = 0; i < 16; ++i) { s0[i] = NEGB; s1[i] = NEGB; }
        }
    } else if (MODE == 2) {
        const unsigned udm = (unsigned)dmax;
#pragma unroll
        for (int g4 = 0; g4 < 4; ++g4) {
            float bb[8]; int dd[8];
#pragma unroll
            for (int e = 0; e < 4; ++e) {
                const int k0 = kidx(4 * g4 + e, h);
                dd[2 * e] = tq - stride * k0; dd[2 * e + 1] = tq - stride * (k0 + 32);
            }
#pragma unroll
            for (int e = 0; e < 8; ++e) { const int ix = dd[e] < 0 ? 0 : (dd[e] > 127 ? 127 : dd[e]); bb[e] = tab[ix]; }
            asm volatile("" : "+v"(bb[0]), "+v"(bb[1]), "+v"(bb[2]), "+v"(bb[3]), "+v"(bb[4]), "+v"(bb[5]), "+v"(bb[6]), "+v"(bb[7]));
#pragma unroll
            for (int e = 0; e < 4; ++e) {
                const int i = 4 * g4 + e;
                const bool v0 = lane_ok && (unsigned)dd[2 * e] < udm, v1 = lane_ok && (unsigned)dd[2 * e + 1] < udm;
                s0[i] = v0 ? s0[i] + bb[2 * e] : NEGB;
                s1[i] = v1 ? s1[i] + bb[2 * e + 1] : NEGB;
            }
        }
    }
}
DI float max2(float a, float b) { return __builtin_amdgcn_fmed3f(a, b, __builtin_inff()); }
DI float max3f(float a, float b, float c) { float r; asm("v_max3_f32 %0, %1, %2, %3" : "=v"(r) : "v"(a), "v"(b), "v"(c)); return r; }
DI float max2f(float a, float b) { float r; asm("v_max_f32_e32 %0, %1, %2" : "=v"(r) : "v"(a), "v"(b)); return r; }
DI float tile_max(const f32x16& s0, const f32x16& s1) {
    float a = max3f(s0[0], s0[1], s1[0]), b = max3f(s0[2], s0[3], s1[1]);
    a = max3f(a, s1[2], s1[3]);
#pragma unroll
    for (int i = 4; i < 16; i += 4) { a = max3f(a, s0[i], s0[i + 1]); b = max3f(b, s0[i + 2], s0[i + 3]); a = max3f(a, s1[i], s1[i + 1]); b = max3f(b, s1[i + 2], s1[i + 3]); }
    return max2f(a, b);
}
typedef float f32x2 __attribute__((ext_vector_type(2)));
constexpr float M_INIT = -64.f;
DI float exp_sum(f32x16& s0, f32x16& s1) {
    f32x2 acc0 = {0.f, 0.f}, acc1 = {0.f, 0.f};
#pragma unroll
    for (int i = 0; i < 16; i += 2) {
        const float a0 = __builtin_amdgcn_exp2f(s0[i]), a1 = __builtin_amdgcn_exp2f(s0[i + 1]), b0 = __builtin_amdgcn_exp2f(s1[i]), b1 = __builtin_amdgcn_exp2f(s1[i + 1]);
        s0[i] = a0; s0[i + 1] = a1; s1[i] = b0; s1[i + 1] = b1;
        acc0 += (f32x2){a0, a1}; acc1 += (f32x2){b0, b1};
    }
    acc0 += acc1;
    return acc0.x + acc0.y;
}
template <int MODE, int NDT>
DI void softmax_step(f32x16& s0, f32x16& s1, f32x16& negm, float& l, f32x16 (&o)[NDT], bool lane_ok) {
    float mx = tile_max(s0, s1);
    if (MODE == 1) mx = lane_ok ? mx : NEGB;
    if (__any(mx > RESCALE_THR)) {
        mx = max2(mx, __shfl_xor(mx, 32));
        const float d = max2(mx, 0.f);
        const float alpha = __builtin_amdgcn_exp2f(-d);
        const float nm = negm[0] - d;
        l *= alpha;
#pragma unroll
        for (int dt = 0; dt < NDT; ++dt)
#pragma unroll
            for (int i = 0; i < 16; ++i) o[dt][i] *= alpha;
#pragma unroll
        for (int i = 0; i < 16; ++i) { s0[i] -= d; s1[i] -= d; negm[i] = nm; }
    }
    f32x2 acc0 = {0.f, 0.f}, acc1 = {0.f, 0.f};
#pragma unroll
    for (int i = 0; i < 16; i += 2) {
        const float a0 = __builtin_amdgcn_exp2f(s0[i]), a1 = __builtin_amdgcn_exp2f(s0[i + 1]), b0 = __builtin_amdgcn_exp2f(s1[i]), b1 = __builtin_amdgcn_exp2f(s1[i + 1]);
        s0[i] = a0; s0[i + 1] = a1; s1[i] = b0; s1[i + 1] = b1;
        acc0 += (f32x2){a0, a1}; acc1 += (f32x2){b0, b1};
    }
    acc0 += acc1;
    const float sum = acc0.x + acc0.y;
    l += (MODE == 1) ? (lane_ok ? sum : 0.f) : sum;
}
template <bool EDGE>
DI void build_vtab(float* T, const float* tab2g, int N, int D0, int i0, int step) {
    for (int idx = i0; idx < 4 * N; idx += step) {
        const int p = idx / N, k = idx - p * N, d = D0 - (k + p);
        float v;
        if (EDGE) v = d < 512 ? 0.f : NEGB;
        else v = d < 0 ? NEGB : (d < 128 ? tab2g[d] : 0.f);
        T[idx] = v;
    }
}
DI void mask_vec(f32x16& s0, f32x16& s1, int h, int tq, const float* T, int N, int D0) {
    const int x0 = D0 - tq + 8 * h, p = x0 & 3;
    const float* base = T + p * N + (x0 - p);
    f32x4 v[8];
#pragma unroll
    for (int kh = 0; kh < 2; ++kh)
#pragma unroll
        for (int g = 0; g < 4; ++g) v[4 * kh + g] = *(const f32x4*)(base + 4 * (g & 1) + 16 * (g >> 1) + 32 * kh);
#pragma unroll
    for (int g = 0; g < 4; ++g) {
        s0[4 * g] += v[g].x; s0[4 * g + 1] += v[g].y; s0[4 * g + 2] += v[g].z; s0[4 * g + 3] += v[g].w;
        s1[4 * g] += v[4 + g].x; s1[4 * g + 1] += v[4 + g].y; s1[4 * g + 2] += v[4 + g].z; s1[4 * g + 3] += v[4 + g].w;
    }
}
template <int MODE, int NDT>
DI void attn_tile(const char* Ks, const char* Vs, const bf16x8 (&qf)[4], int r_in, int h_in, f32x16& negm, float& l, f32x16 (&o)[NDT],
                  int tq, int stride, int dmax, bool lane_ok, const float* tab) {
    int lane_ = r_in + 32 * h_in;
    asm volatile("" : "+v"(lane_), "+v"(tq));
    const int r = lane_ & 31, h = lane_ >> 5;
    f32x16 s0, s1;
    qk_tile(Ks, qf, r, h, negm, s0, s1);
    bf16x8 vf0[4];
    v_prefetch(Vs, r, h, vf0);
    if (MODE == 2) mask_tile<2>(s0, s1, h, tq, stride, dmax, lane_ok, tab);
    if (MODE == 3) mask_vec(s0, s1, h, tq, tab, stride, dmax);
    softmax_step<(MODE == 1 || MODE == 3) ? 1 : 0, NDT>(s0, s1, negm, l, o, lane_ok);
    bf16x8 pf[4];
    pack_p(s0, s1, pf);
    if (MODE == 1 || MODE == 3) {
#pragma unroll
        for (int i = 0; i < 4; ++i) {
            u32x4 v = __builtin_bit_cast(u32x4, pf[i]);
            v.x = lane_ok ? v.x : 0u; v.y = lane_ok ? v.y : 0u; v.z = lane_ok ? v.z : 0u; v.w = lane_ok ? v.w : 0u;
            pf[i] = __builtin_bit_cast(bf16x8, v);
        }
    }
    pv_tile<NDT>(Vs, vf0, pf, r, h, o);
}

DI void nsa_dma(const bf16_t* kbase, int kpitch, const bf16_t* vbase, int vpitch, int krow0, int vcol0, char* Kbuf, char* Vbuf, bool with_v, int lane, int widu) {
    const int rho = 8 * widu + (lane >> 3), c = (lane & 7) ^ ((rho >> 1) & 7);
    glds16(kbase + (size_t)(krow0 + kperm(rho)) * kpitch + c * 8, Kbuf + widu * 1024);
    if (with_v) glds16(vbase + (size_t)rho * vpitch + vcol0 + c * 8, Vbuf + widu * 1024);
}

DI unsigned ord_key(float f) { const unsigned u = __float_as_uint(f); return (u & 0x80000000u) ? ~u : (u | 0x80000000u); }
DI float unord_key(unsigned k) { return __uint_as_float((k & 0x80000000u) ? (k & 0x7fffffffu) : ~k); }
#define CE_DESC(a, b) do { const unsigned hi_ = (a) > (b) ? (a) : (b); const unsigned lo_ = (a) > (b) ? (b) : (a); (a) = hi_; (b) = lo_; } while (0)
DI void sort16_desc(unsigned (&k)[16]) {
#pragma unroll
    for (int size = 2; size <= 16; size <<= 1)
#pragma unroll
        for (int stride = size >> 1; stride > 0; stride >>= 1)
#pragma unroll
            for (int i = 0; i < 16; ++i) {
                const int j = i ^ stride;
                if (j > i) { if ((i & size) == 0) CE_DESC(k[i], k[j]); else CE_DESC(k[j], k[i]); }
            }
}
DI void merge16_desc(unsigned (&v)[16], const unsigned (&k)[16]) {
#pragma unroll
    for (int i = 0; i < 16; ++i) v[i] = v[i] > k[15 - i] ? v[i] : k[15 - i];
#pragma unroll
    for (int stride = 8; stride > 0; stride >>= 1)
#pragma unroll
        for (int i = 0; i < 16; ++i) { const int j = i ^ stride; if (j > i) CE_DESC(v[i], v[j]); }
}
DI void sort8_desc(unsigned (&k)[8]) {
#pragma unroll
    for (int size = 2; size <= 8; size <<= 1)
#pragma unroll
        for (int stride = size >> 1; stride > 0; stride >>= 1)
#pragma unroll
            for (int i = 0; i < 8; ++i) {
                const int j = i ^ stride;
                if (j > i) { if ((i & size) == 0) CE_DESC(k[i], k[j]); else CE_DESC(k[j], k[i]); }
            }
}
template <int CTRL> DI unsigned dpp_mov(unsigned x) { return (unsigned)__builtin_amdgcn_mov_dpp((int)x, CTRL, 0xf, 0xf, true); }

constexpr int NSA_K = 0, NSA_V = 16384, NSA_IMPM = NSA_V + 2 * 64 * VT_PITCH, NSA_IMPC = NSA_IMPM + 64 * 65 * 4, NSA_MASK = NSA_IMPC + 64 * 65 * 4,
              NSA_TAB = NSA_MASK + 512, NSA_OACC = NSA_TAB + 4 * 128 * 4, NSA_VTAB = NSA_OACC + 256 * 68 * 4, NSA_ETAB = NSA_VTAB + 4 * 4 * 272 * 4, NSA_END = NSA_ETAB + 4 * 144 * 4;
constexpr int NSA_VN = 272, NSA_VD0 = 191, NSA_EN = 144, NSA_ED0 = 575;
static_assert(NSA_END <= LDS_BYTES && (NSA_IMPM % 16) == 0 && (NSA_OACC % 16) == 0, "NSA LDS map");
#define NSA_KB(i) (smem + NSA_K + ((i) & 1) * 8192)
#define NSA_VB(i) (smem + NSA_V + ((i) & 1) * (64 * VT_PITCH))

DI void nsa_unit(const Params& P, char* smem, int b, int g, int cur) {
    const int tid = ltid(), lane = tid & 63, wid = tid >> 6, r = lane & 31, h = lane >> 5, hh = r >> 3, ti = r & 7;
    const int tl = 8 * wid + ti, t = 64 * cur + tl;
    const size_t tg = (size_t)b * SEQ + t;
    const int bg = b * 2 + g, head = g * 4 + hh;
    float* impM = (float*)(smem + NSA_IMPM); float* impC = (float*)(smem + NSA_IMPC);
    unsigned long long* mask64 = (unsigned long long*)(smem + NSA_MASK);
    float* tabL = (float*)(smem + NSA_TAB);
    const float* tabG = (const float*)(P.ws + OFF_TAB);
    __syncthreads();
    for (int i = tid; i < 4 * 128; i += NTHREADS) tabL[i] = tabG[(g * 4) * 128 + i];
    {
        const int q = tid >> 7;
        build_vtab<false>((float*)(smem + NSA_VTAB) + q * 4 * NSA_VN, tabG + (g * 4 + q) * 128, NSA_VN, NSA_VD0, tid & 127, 128);
        build_vtab<true>((float*)(smem + NSA_ETAB), tabG, NSA_EN, NSA_ED0, tid, NTHREADS);
    }
    const float* vtab = (const float*)(smem + NSA_VTAB) + hh * 4 * NSA_VN;
    const float* etab = (const float*)(smem + NSA_ETAB);
    for (int i = tid; i < 2 * 64 * 65; i += NTHREADS) impM[i] = 0.f;
    const float* tab = tabL + hh * 128;
    bf16x8 qf[4];
    {
        const bf16_t* qbase = (const bf16_t*)(P.ws + OFF_QN);
#pragma unroll
        for (int ks = 0; ks < 4; ++ks) qf[ks] = *(const bf16x8*)(qbase + qblk(tg, g * 32 + hh * 8 + 2 * ks + h));
    }
    const float* gp = (const float*)(P.ws + OFF_GATES) + tg * 24 + head * 3;
    const float gate_c = gp[0], gate_s = gp[1], gate_w = gp[2];
    float* oaccL = (float*)(smem + NSA_OACC) + (tl * 4 + hh) * 68 + 4 * h;
    const int widu = __builtin_amdgcn_readfirstlane(wid);

    const bf16_t* kcmp = (const bf16_t*)(P.ws + OFF_KCMP) + (size_t)bg * 256 * 64;
    const bf16_t* vcmpT = (const bf16_t*)(P.ws + OFF_VCMPT) + (size_t)bg * 64 * 256;
    const int nvis = 4 * cur + 3;
    const int nct = (nvis + 63) >> 6;
    float mc = NEGB, lc = 0.f;
    nsa_dma(kcmp, 64, vcmpT, 256, 0, 0, NSA_KB(0), NSA_VB(0), false, lane, widu);
    __syncthreads();
    for (int ct = 0; ct < nct; ++ct) {
        if (ct + 1 < nct) nsa_dma(kcmp, 64, vcmpT, 256, 64 * (ct + 1), 64 * (ct + 1), NSA_KB(ct + 1), NSA_VB(ct + 1), false, lane, widu);
        f32x16 s0, s1, zero;
#pragma unroll
        for (int i = 0; i < 16; ++i) zero[i] = 0.f;
        int lane_ = lane, tq_ = t - 31 - 16 * 64 * ct;
        asm volatile("" : "+v"(lane_), "+v"(tq_));
        qk_tile(NSA_KB(ct), qf, lane_ & 31, lane_ >> 5, zero, s0, s1);
        if (64 * cur < 1167 + 1024 * ct) mask_tile<2>(s0, s1, lane_ >> 5, tq_, 16, 0x7fffffff, true, tab);
        float mx = tile_max(s0, s1);
        mx = max2(mx, __shfl_xor(mx, 32));
        const float mn = max2(mc, mx);
        const float alpha = __builtin_amdgcn_exp2f(mc - mn);
        mc = mn;
        const float mref = max2(mn, -1e20f);
#pragma unroll
        for (int i = 0; i < 16; ++i) { s0[i] -= mref; s1[i] -= mref; }
        lc = lc * alpha + exp_sum(s0, s1);
        __syncthreads();
    }
    {
        const float lt = lc + __shfl_xor(lc, 32);
        const float inv = lt > 0.f ? 1.0f / lt : 0.f;
        f32x16 oc[2];
#pragma unroll
        for (int i = 0; i < 16; ++i) { oc[0][i] = 0.f; oc[1][i] = 0.f; }
        nsa_dma(kcmp, 64, vcmpT, 256, 0, 0, NSA_KB(0), NSA_VB(0), true, lane, widu);
        f32x16 negmc;
#pragma unroll
        for (int i = 0; i < 16; ++i) negmc[i] = -mc;
        __syncthreads();
        for (int ct = 0; ct < nct; ++ct) {
            if (ct + 1 < nct) nsa_dma(kcmp, 64, vcmpT, 256, 64 * (ct + 1), 64 * (ct + 1), NSA_KB(ct + 1), NSA_VB(ct + 1), true, lane, widu);
            f32x16 s0, s1;
            int lane_ = lane, tq_ = t - 31 - 16 * 64 * ct;
            asm volatile("" : "+v"(lane_), "+v"(tq_));
            qk_tile(NSA_KB(ct), qf, lane_ & 31, lane_ >> 5, negmc, s0, s1);
            bf16x8 vf0[4];
            v_prefetch(NSA_VB(ct), lane_ & 31, lane_ >> 5, vf0);
            if (64 * cur < 1167 + 1024 * ct) mask_tile<2>(s0, s1, lane_ >> 5, tq_, 16, 0x7fffffff, true, tab);
#pragma unroll
            for (int i = 0; i < 16; ++i) {
                s0[i] = __builtin_amdgcn_exp2f(s0[i]) * inv;
                s1[i] = __builtin_amdgcn_exp2f(s1[i]) * inv;
            }
#pragma unroll
            for (int kh = 0; kh < 2; ++kh)
#pragma unroll
                for (int gi = 0; gi < 4; ++gi) {
                    const float p0 = kh ? s1[4 * gi] : s0[4 * gi], p1 = kh ? s1[4 * gi + 1] : s0[4 * gi + 1], p2 = kh ? s1[4 * gi + 2] : s0[4 * gi + 2], p3 = kh ? s1[4 * gi + 3] : s0[4 * gi + 3];
                    float hv = (p0 + p1) + (p2 + 0.5f * p3), cv = 0.5f * p3;
                    hv += __shfl_xor(hv, 8); hv += __shfl_xor(hv, 16);
                    cv += __shfl_xor(cv, 8); cv += __shfl_xor(cv, 16);
                    if (hh == 0) {
                        const int j = 16 * ct + 8 * kh + (gi & 1) + 2 * (lane_ >> 5) + 4 * (gi >> 1);
                        impM[tl * 65 + j] = hv;
                        impC[tl * 65 + j + 1] = cv;
                    }
                }
            bf16x8 pf[4];
            pack_p(s0, s1, pf);
            pv_tile<2>(NSA_VB(ct), vf0, pf, lane_ & 31, lane_ >> 5, oc);
            __syncthreads();
        }
#pragma unroll
        for (int dt = 0; dt < 2; ++dt)
#pragma unroll
            for (int gi = 0; gi < 4; ++gi)
                *(f32x4*)(oaccL + 32 * dt + 8 * gi) = (f32x4){gate_c * oc[dt][4 * gi], gate_c * oc[dt][4 * gi + 1], gate_c * oc[dt][4 * gi + 2], gate_c * oc[dt][4 * gi + 3]};
    }
    {
        const int tk = 8 * wid + (lane >> 3), jb = (lane & 7) * 8;
        unsigned key[8], sk[8];
#pragma unroll
        for (int e = 0; e < 8; ++e) {
            const int j = jb + e;
            const float imp = impM[tk * 65 + j] + impC[tk * 65 + j];
            const float my = (j == 0 || j == cur || j == cur - 1) ? 1e9f : (j <= cur ? imp : NEGB);
            key[e] = (ord_key(my) & ~63u) | (unsigned)(63 - j);
            sk[e] = key[e];
        }
        sort8_desc(sk);
        unsigned v[16], k2[16];
#pragma unroll
        for (int i = 0; i < 8; ++i) { v[i] = sk[i]; v[15 - i] = dpp_mov<0xB1>(sk[i]); }
#pragma unroll
        for (int stride = 8; stride > 0; stride >>= 1)
#pragma unroll
            for (int i = 0; i < 16; ++i) { const int j = i ^ stride; if (j > i) CE_DESC(v[i], v[j]); }
#pragma unroll
        for (int i = 0; i < 16; ++i) k2[i] = dpp_mov<0x4E>(v[i]);
        merge16_desc(v, k2);
#pragma unroll
        for (int i = 0; i < 16; ++i) k2[i] = dpp_mov<0x141>(v[i]);
        merge16_desc(v, k2);
        const unsigned thr = v[15];
        unsigned bits = 0;
#pragma unroll
        for (int e = 0; e < 8; ++e) bits |= (key[e] >= thr && (jb + e) <= cur) ? (1u << e) : 0u;
        ((unsigned char*)mask64)[tk * 8 + (lane & 7)] = (unsigned char)bits;
    }
    __syncthreads();
    const unsigned long long mymask = mask64[tl];
    unsigned long long uni;
    {
        const unsigned long long mm = mask64[lane];
        unsigned lo = (unsigned)mm, hi2 = (unsigned)(mm >> 32);
#pragma unroll
        for (int o = 1; o < 64; o <<= 1) { lo |= __shfl_xor(lo, o); hi2 |= __shfl_xor(hi2, o); }
        uni = ((unsigned long long)hi2 << 32) | lo;
    }
    {
        const bf16_t* kb = (const bf16_t*)(P.ws + OFF_KS) + (size_t)b * SEQ * 128 + g * 64;
        const bf16_t* vb = (const bf16_t*)(P.ws + OFF_VST) + (size_t)bg * 64 * SEQ;
        float l = 0.f;
        f32x16 negm;
#pragma unroll
        for (int i = 0; i < 16; ++i) negm[i] = -M_INIT;
        f32x16 o[2];
#pragma unroll
        for (int i = 0; i < 16; ++i) { o[0][i] = 0.f; o[1][i] = 0.f; }
        int jc = 0;
        while (jc <= cur && !((uni >> jc) & 1ull)) ++jc;
        int jn = jc + 1;
        while (jn <= cur && !((uni >> jn) & 1ull)) ++jn;
        if (jc <= cur) nsa_dma(kb, 128, vb, SEQ, 64 * jc, 64 * jc, NSA_KB(0), NSA_VB(0), true, lane, widu);
        __syncthreads();
        for (int it = 0; jc <= cur; ++it) {
            if (jn <= cur) nsa_dma(kb, 128, vb, SEQ, 64 * jn, 64 * jn, NSA_KB(it + 1), NSA_VB(it + 1), true, lane, widu);
            const bool ok = (mymask >> jc) & 1ull;
            if (jc >= cur - 2) attn_tile<3, 2>(NSA_KB(it), NSA_VB(it), qf, r, h, negm, l, o, t - 64 * jc, NSA_VN, NSA_VD0, ok, vtab);
            else attn_tile<1, 2>(NSA_KB(it), NSA_VB(it), qf, r, h, negm, l, o, 0, 1, 0, ok, tab);
            __syncthreads();
            int jnn = jn + 1;
            while (jnn <= cur && !((uni >> jnn) & 1ull)) ++jnn;
            jc = jn; jn = jnn;
        }
        const float lt = l + __shfl_xor(l, 32);
        const float sc = lt > 0.f ? gate_s / lt : 0.f;
#pragma unroll
        for (int dt = 0; dt < 2; ++dt)
#pragma unroll
            for (int gi = 0; gi < 4; ++gi) {
                f32x4 a = *(const f32x4*)(oaccL + 32 * dt + 8 * gi);
                a.x += sc * o[dt][4 * gi]; a.y += sc * o[dt][4 * gi + 1]; a.z += sc * o[dt][4 * gi + 2]; a.w += sc * o[dt][4 * gi + 3];
                *(f32x4*)(oaccL + 32 * dt + 8 * gi) = a;
            }
    }
    {
        const bf16_t* kb = (const bf16_t*)(P.ws + OFF_KW) + (size_t)b * SEQ * 128 + g * 64;
        const bf16_t* vb = (const bf16_t*)(P.ws + OFF_VWT) + (size_t)bg * 64 * SEQ;
        float l = 0.f;
        f32x16 negm;
#pragma unroll
        for (int i = 0; i < 16; ++i) negm[i] = -M_INIT;
        f32x16 o[2];
#pragma unroll
        for (int i = 0; i < 16; ++i) { o[0][i] = 0.f; o[1][i] = 0.f; }
        const int j0 = cur >= 8 ? cur - 8 : 0;
        nsa_dma(kb, 128, vb, SEQ, 64 * j0, 64 * j0, NSA_KB(0), NSA_VB(0), true, lane, widu);
        __syncthreads();
        for (int j = j0; j <= cur; ++j) {
            const int it = j - j0;
            if (j + 1 <= cur) nsa_dma(kb, 128, vb, SEQ, 64 * (j + 1), 64 * (j + 1), NSA_KB(it + 1), NSA_VB(it + 1), true, lane, widu);
            if (j >= cur - 2) attn_tile<3, 2>(NSA_KB(it), NSA_VB(it), qf, r, h, negm, l, o, t - 64 * j, NSA_VN, NSA_VD0, true, vtab);
            else if (j == cur - 8) attn_tile<3, 2>(NSA_KB(it), NSA_VB(it), qf, r, h, negm, l, o, t - 64 * j, NSA_EN, NSA_ED0, true, etab);
            else attn_tile<0, 2>(NSA_KB(it), NSA_VB(it), qf, r, h, negm, l, o, 0, 1, 0, true, tab);
            __syncthreads();
        }
        const float lt = l + __shfl_xor(l, 32);
        const float sc = lt > 0.f ? gate_w / lt : 0.f;
        bf16_t* mp = (bf16_t*)(P.ws + OFF_H) + tg * DM + g * 256 + hh * 64;
#pragma unroll
        for (int dt = 0; dt < 2; ++dt)
#pragma unroll
            for (int gi = 0; gi < 4; ++gi) {
                f32x4 a = *(const f32x4*)(oaccL + 32 * dt + 8 * gi);
                a.x += sc * o[dt][4 * gi]; a.y += sc * o[dt][4 * gi + 1]; a.z += sc * o[dt][4 * gi + 2]; a.w += sc * o[dt][4 * gi + 3];
                st_bf4(mp + 32 * dt + 8 * gi + 4 * h, a, 1.f);
            }
    }
}

constexpr int DF_K = 0, DF_V = 32768, DF_TAB = DF_V + 2 * 128 * VT_PITCH, DF_O2 = DF_TAB + 4 * 336 * 4, DF_END = DF_O2 + 128 * 129 * 4;
constexpr int DF_VN = 336, DF_VD0 = 223;
static_assert(DF_END <= LDS_BYTES && (DF_TAB % 16) == 0, "diff LDS map");

DI void diff_unit(const Params& P, char* smem, int b, int hd, int qi, float lam) {
    const int tid = ltid(), lane = tid & 63, wid = tid >> 6, r = lane & 31, h = lane >> 5, qs = wid & 3, mp = wid >> 2;
    const int t0 = 128 * qi, t = t0 + 32 * qs + r;
    const size_t tg = (size_t)b * SEQ + t;
    float* tabL = (float*)(smem + DF_TAB);
    float* o2b = (float*)(smem + DF_O2);
    __syncthreads();
    build_vtab<false>(tabL, (const float*)(P.ws + OFF_TAB) + (8 + hd) * 128, DF_VN, DF_VD0, tid, NTHREADS);
    bf16x8 qf[4];
    {
        const bf16_t* qbase = (const bf16_t*)(P.ws + OFF_DQ);
#pragma unroll
        for (int ks = 0; ks < 4; ++ks) qf[ks] = *(const bf16x8*)(qbase + qblk(tg, (hd * 2 + mp) * 8 + 2 * ks + h));
    }
    const bf16_t* kb = (const bf16_t*)(P.ws + OFF_DK) + (size_t)b * SEQ * 512 + hd * 128;
    const bf16_t* vb = (const bf16_t*)(P.ws + OFF_DVT) + (size_t)(b * 4 + hd) * 128 * SEQ;
    const int widu = __builtin_amdgcn_readfirstlane(wid);
#define DF_DMA(j, bi) do { _Pragma("unroll") for (int i_ = 0; i_ < 2; ++i_) { const int q_ = 2 * widu + i_; \
        const int rho_ = 8 * (q_ & 7) + (lane >> 3), ck_ = (lane & 7) ^ ((rho_ >> 1) & 7); \
        glds16(kb + (size_t)(64 * (j) + kperm(rho_)) * 512 + (q_ >> 3) * 64 + ck_ * 8, smem + DF_K + ((bi) & 1) * 16384 + q_ * 1024); \
        const int d_ = 8 * q_ + (lane >> 3), cv_ = (lane & 7) ^ ((d_ >> 1) & 7); \
        glds16(vb + (size_t)d_ * SEQ + 64 * (j) + cv_ * 8, smem + DF_V + ((bi) & 1) * (128 * VT_PITCH) + q_ * 1024); } } while (0)
    float l = 0.f;
    f32x16 negm;
#pragma unroll
    for (int i = 0; i < 16; ++i) negm[i] = -M_INIT;
    f32x16 o[4];
#pragma unroll
    for (int dt = 0; dt < 4; ++dt)
#pragma unroll
        for (int i = 0; i < 16; ++i) o[dt][i] = 0.f;
    const int ntile = 2 * qi + 2;
    const int tmin = t0 + 32 * qs;
    DF_DMA(0, 0);
    __syncthreads();
    for (int j = 0; j < ntile; ++j) {
        if (j + 1 < ntile) DF_DMA(j + 1, j + 1);
        const char* Ks = smem + DF_K + (j & 1) * 16384 + mp * 8192;
        const char* Vs = smem + DF_V + (j & 1) * (128 * VT_PITCH);
        if (64 * j <= tmin + 31) {
            if (64 * j + 63 + 128 > tmin) attn_tile<3, 4>(Ks, Vs, qf, r, h, negm, l, o, t - 64 * j, DF_VN, DF_VD0, true, tabL);
            else attn_tile<0, 4>(Ks, Vs, qf, r, h, negm, l, o, 0, 1, 0, true, tabL);
        }
        __syncthreads();
    }
#undef DF_DMA
    const float lt = l + __shfl_xor(l, 32);
    const float inv = 1.0f / lt;
    const int tloc = 32 * qs + r;
    if (mp == 1) {
#pragma unroll
        for (int dt = 0; dt < 4; ++dt)
#pragma unroll
            for (int i = 0; i < 16; ++i) o2b[tloc * 129 + 32 * dt + crow(i, h)] = lam * inv * o[dt][i];
    }
    __syncthreads();
    if (mp == 0) {
        float ss = 0.f;
#pragma unroll
        for (int dt = 0; dt < 4; ++dt)
#pragma unroll
            for (int i = 0; i < 16; ++i) { const float v = o[dt][i] * inv - o2b[tloc * 129 + 32 * dt + crow(i, h)]; o[dt][i] = v; ss += v * v; }
        ss += __shfl_xor(ss, 32);
        const float rn = __builtin_amdgcn_rsqf(ss * (1.0f / 128.0f) + RMS_EPS) * 0.8f;
        bf16_t* mpx = (bf16_t*)(P.ws + OFF_H) + tg * DM + 512 + hd * 128;
#pragma unroll
        for (int dt = 0; dt < 4; ++dt)
#pragma unroll
            for (int gi = 0; gi < 4; ++gi) {
                const int d = 32 * dt + 8 * gi + 4 * h;
                const f32x4 gg = *(const f32x4*)(P.subln_g + d);
                f32x4 v = {o[dt][4 * gi] * rn * gg.x, o[dt][4 * gi + 1] * rn * gg.y, o[dt][4 * gi + 2] * rn * gg.z, o[dt][4 * gi + 3] * rn * gg.w};
                st_bf4(mpx + d, v, 1.f);
            }
    }
}

DI void phase_attention(const Params& P, char* smem) {
    float lam;
    {
        const int lane = ltid() & 63;
        const float a = wave_sum(P.lam_q1[lane] * P.lam_k1[lane]);
        const float b2 = wave_sum(P.lam_q2[lane] * P.lam_k2[lane]);
        lam = __expf(a) - __expf(b2) + 0.2f;
    }
    for (int u = blockIdx.x; u < 4096; u += gridDim.x) {
        const int k = u >> 1;
        if (((u + (u >> 8)) & 1) == 0) {
            const int qi = 31 - (k >> 6), bh = k & 63;
#ifndef REP_KIND
#define REP_KIND 0
#endif
            for (int rp = 0; rp < (REP_KIND == 1 ? 2 : 1); ++rp)
            diff_unit(P, smem, bh >> 2, bh & 3, qi, lam);
        } else {
            const int cur = 63 - (k >> 5), bgi = k & 31;
            for (int rp = 0; rp < (REP_KIND == 2 ? 2 : 1); ++rp)
            nsa_unit(P, smem, bgi >> 1, bgi & 1, cur);
        }
    }
}

#define INS16(v, c) do { _Pragma("unroll") for (int e_ = 0; e_ < 16; ++e_) { const unsigned hi_ = (v)[e_] > (c) ? (v)[e_] : (c); (c) = (v)[e_] > (c) ? (c) : (v)[e_]; (v)[e_] = hi_; } } while (0)
constexpr int RT_SK = 0, RT_SCR = 65536, RT_END = RT_SCR + 8 * 2048;

DI void phase_retrieval(const Params& P, char* smem, int task0 = 0, int task1 = 2048 * 8, int bi = blockIdx.x, int nb = gridDim.x) {
    const int tid = ltid(), lane = tid & 63, wid = tid >> 6, r = lane & 31, h = lane >> 5;
    __syncthreads();
    {
        const bf16_t* sk = (const bf16_t*)(P.ws + OFF_SK);
        for (int i = tid; i < 2 * 128 * 16; i += NTHREADS) {
            const int row = i >> 4, c = i & 15;
            *(u32x4*)(smem + RT_SK + row * 256 + ((c ^ (row & 15)) << 4)) = *(const u32x4*)(sk + (size_t)row * 128 + c * 8);
        }
    }
    __syncthreads();
    unsigned char* scr = (unsigned char*)(smem + RT_SCR) + wid * 2048 + lane * 32;
    const int gw = bi * 8 + wid, NGW = nb * 8;
    for (int task = task0 + gw; task < task1; task += NGW) {
        const int tt = task >> 3, hp = task & 7;
        const size_t tok = (size_t)tt * 32 + r;
        unsigned L[2][16];
#pragma unroll
        for (int p = 0; p < 2; ++p) {
            bf16x8 qf[8];
            {
                const bf16_t* qb = (const bf16_t*)(P.ws + OFF_QP) + ((size_t)tt * 16 + hp * 2 + p) * 4096 + (size_t)(h * 32 + r) * 8;
#pragma unroll
                for (int ks = 0; ks < 8; ++ks) qf[ks] = *(const bf16x8*)(qb + ks * 512);
            }
            unsigned v[16];
#pragma unroll
            for (int kt = 0; kt < 4; ++kt) {
                f32x16 acc;
#pragma unroll
                for (int i = 0; i < 16; ++i) acc[i] = 0.f;
                const char* krow = smem + RT_SK + (p * 128 + 32 * kt + r) * 256;
                bf16x8 kf[8];
#pragma unroll
                for (int ks = 0; ks < 8; ++ks) kf[ks] = *(const bf16x8*)(krow + (((2 * ks + h) ^ (r & 15)) << 4));
#pragma unroll
                for (int ks = 0; ks < 8; ++ks) acc = MFMA32(kf[ks], qf[ks], acc);
                unsigned k[16];
#pragma unroll
                for (int i = 0; i < 16; ++i) k[i] = (ord_key(acc[i]) & ~127u) | (unsigned)(127 - (32 * kt + crow(i, h)));
                sort16_desc(k);
                if (kt == 0) {
#pragma unroll
                    for (int e = 0; e < 16; ++e) v[e] = k[e];
                } else merge16_desc(v, k);
            }
            unsigned w2[16];
#pragma unroll
            for (int e = 0; e < 16; ++e) w2[e] = (unsigned)__shfl_xor((int)v[e], 32);
            merge16_desc(v, w2);
#pragma unroll
            for (int e = 0; e < 16; ++e) L[p][e] = v[e];
        }
        float s0[16], s1[16];
#pragma unroll
        for (int e = 0; e < 16; ++e) { s0[e] = unord_key(L[0][e] & ~127u); s1[e] = unord_key(L[1][e] & ~127u); }
        unsigned f[16];
        {
            unsigned ca[16], cb[16];
#pragma unroll
            for (int e = 0; e < 16; ++e) { ca[e] = 0u; cb[e] = 0u; }
            const unsigned hm2 = 0u - (unsigned)h;
            int n = 0;
            unsigned prev = 0u;
#pragma unroll
            for (int a = 0; a < 16; ++a)
#pragma unroll
                for (int bb = 0; bb < 16; ++bb)
                    if ((a + 1) * (bb + 1) <= 16) {
                        const unsigned c = (ord_key(s0[a] + s1[bb]) & ~255u) | (unsigned)(255 - (a * 16 + bb));
                        if (n & 1) { const unsigned sel = prev ^ ((prev ^ c) & hm2); const int m = n >> 1; if (m < 16) ca[m] = sel; else cb[m - 16] = sel; }
                        prev = c;
                        ++n;
                    }
            sort16_desc(ca); sort16_desc(cb);
            merge16_desc(ca, cb);
            unsigned w2[16];
#pragma unroll
            for (int e = 0; e < 16; ++e) w2[e] = (unsigned)__shfl_xor((int)ca[e], 32);
            merge16_desc(ca, w2);
#pragma unroll
            for (int e = 0; e < 16; ++e) f[e] = ca[e];
        }
#pragma unroll
        for (int e = 0; e < 16; e += 4) {
            const unsigned i0 = (127u - (L[0][e] & 127u)) | ((127u - (L[0][e + 1] & 127u)) << 8) | ((127u - (L[0][e + 2] & 127u)) << 16) | ((127u - (L[0][e + 3] & 127u)) << 24);
            const unsigned i1 = (127u - (L[1][e] & 127u)) | ((127u - (L[1][e + 1] & 127u)) << 8) | ((127u - (L[1][e + 2] & 127u)) << 16) | ((127u - (L[1][e + 3] & 127u)) << 24);
            *(unsigned*)(scr + e) = i0; *(unsigned*)(scr + 16 + e) = i1;
        }
        const float best0 = unord_key(f[0] & ~255u);
        float ex[16]; float sum = 0.f;
#pragma unroll
        for (int e = 0; e < 16; ++e) { ex[e] = __expf(unord_key(f[e] & ~255u) - best0); sum += ex[e]; }
        const float inv = 1.0f / sum;
        int* eo = (int*)(P.ws + OFF_EID) + tok * 128 + hp * 16 + 8 * h;
        float* go = (float*)(P.ws + OFF_GW) + tok * 128 + hp * 16 + 8 * h;
        int eid[8]; float gg[8];
        const unsigned hm = 0u - (unsigned)h;
#pragma unroll
        for (int e = 0; e < 8; ++e) {
            const unsigned key = f[e] ^ ((f[e] ^ f[8 + e]) & hm);
            const int pos = 255 - (int)(key & 255u), a = pos >> 4, bb = pos & 15;
            eid[e] = (int)scr[a] * 128 + (int)scr[16 + bb];
            const unsigned xe = __float_as_uint(ex[e]) ^ ((__float_as_uint(ex[e]) ^ __float_as_uint(ex[8 + e])) & hm);
            gg[e] = __uint_as_float(xe) * inv;
        }
        *(int4*)(eo) = make_int4(eid[0], eid[1], eid[2], eid[3]); *(int4*)(eo + 4) = make_int4(eid[4], eid[5], eid[6], eid[7]);
        *(f32x4*)(go) = (f32x4){gg[0], gg[1], gg[2], gg[3]}; *(f32x4*)(go + 4) = (f32x4){gg[4], gg[5], gg[6], gg[7]};
    }
}

DI float ub0(unsigned w) { return (float)(w & 0xffu); }
DI float ub1(unsigned w) { return (float)((w >> 8) & 0xffu); }
DI float ub2(unsigned w) { return (float)((w >> 16) & 0xffu); }
DI float ub3(unsigned w) { return (float)(w >> 24); }

typedef _Float16 h16x2_t __attribute__((ext_vector_type(2)));
DI float dot2h(unsigned a, unsigned b, float c) { return __builtin_amdgcn_fdot2(__builtin_bit_cast(h16x2_t, a), __builtin_bit_cast(h16x2_t, b), c, false); }
DI float dot16_u8(const unsigned (&hp)[8], u32x4 w) {
    float a = dot2h(hp[0], __builtin_amdgcn_perm(0x64646464u, w.x, 0x04010400u), 0.f);
    a = dot2h(hp[1], __builtin_amdgcn_perm(0x64646464u, w.x, 0x04030402u), a);
    a = dot2h(hp[2], __builtin_amdgcn_perm(0x64646464u, w.y, 0x04010400u), a);
    a = dot2h(hp[3], __builtin_amdgcn_perm(0x64646464u, w.y, 0x04030402u), a);
    a = dot2h(hp[4], __builtin_amdgcn_perm(0x64646464u, w.z, 0x04010400u), a);
    a = dot2h(hp[5], __builtin_amdgcn_perm(0x64646464u, w.z, 0x04030402u), a);
    a = dot2h(hp[6], __builtin_amdgcn_perm(0x64646464u, w.w, 0x04010400u), a);
    a = dot2h(hp[7], __builtin_amdgcn_perm(0x64646464u, w.w, 0x04030402u), a);
    return a;
}
template <int NSL, int SHIFT>
DI void slice_list(int eme0, int eme1, int lane, int sub, int* slot, int& b_lo, int& b_hi) {
    const int s0 = eme0 >> SHIFT, s1 = eme1 >> SHIFT;
    int cum = 0, r0 = 0, r1 = 0, c_lo = 0, c_hi = 128;
#pragma unroll
    for (int t = 0; t < NSL; ++t) {
        const unsigned long long m0 = __ballot(s0 == t), m1 = __ballot(s1 == t);
        const int n0 = __popcll(m0), n1 = __popcll(m1);
        const int k0 = __builtin_amdgcn_mbcnt_hi((unsigned)(m0 >> 32), __builtin_amdgcn_mbcnt_lo((unsigned)m0, 0u));
        const int k1 = __builtin_amdgcn_mbcnt_hi((unsigned)(m1 >> 32), __builtin_amdgcn_mbcnt_lo((unsigned)m1, 0u));
        r0 = (s0 == t) ? cum + k0 : r0;
        r1 = (s1 == t) ? cum + n0 + k1 : r1;
        if (t == sub) c_lo = cum;
        cum += n0 + n1;
        if (t == sub) c_hi = cum;
    }
    slot[r0] = lane;
    slot[r1] = 64 + lane;
    b_lo = (c_lo + 15) >> 4; b_hi = (c_hi + 15) >> 4;
}
template <int NSL, int SHIFT>
DI void slice_list_all(int eme0, int eme1, int lane, int* slotp, int* cump) {
    const int s0 = eme0 >> SHIFT, s1 = eme1 >> SHIFT;
    int cum = 0, r0 = 0, r1 = 0;
#pragma unroll
    for (int t = 0; t < NSL; ++t) {
        const unsigned long long m0 = __ballot(s0 == t), m1 = __ballot(s1 == t);
        const int n0 = __popcll(m0), n1 = __popcll(m1);
        const int k0 = __builtin_amdgcn_mbcnt_hi((unsigned)(m0 >> 32), __builtin_amdgcn_mbcnt_lo((unsigned)m0, 0u));
        const int k1 = __builtin_amdgcn_mbcnt_hi((unsigned)(m1 >> 32), __builtin_amdgcn_mbcnt_lo((unsigned)m1, 0u));
        r0 = (s0 == t) ? cum + k0 : r0;
        r1 = (s1 == t) ? cum + n0 + k1 : r1;
        if (lane == 0) cump[t] = cum;
        cum += n0 + n1;
    }
    if (lane == 0) cump[NSL] = cum;
    slotp[r0] = lane;
    slotp[r1] = 64 + lane;
}
constexpr int KEY_SUB = 4, KEY_SHIFT = 12;
constexpr int VAL_SUB = 4, VAL_SHIFT = 12, VAL_GRP = 4;
DI int dot16_i8(const unsigned (&hq4)[4], u32x4 w) {
    int a = __builtin_amdgcn_sdot4((int)hq4[0], (int)w.x, 0, false);
    a = __builtin_amdgcn_sdot4((int)hq4[1], (int)w.y, a, false);
    a = __builtin_amdgcn_sdot4((int)hq4[2], (int)w.z, a, false);
    return __builtin_amdgcn_sdot4((int)hq4[3], (int)w.w, a, false);
}
DI void phase_experts(const Params& P, char* smem, int row0 = 0, int row1 = NTOK, int bi = blockIdx.x, int nb = gridDim.x) {
    const int tid = ltid(), lane = tid & 63, wid = tid >> 6;
    const int gw = bi * 8 + wid, NGW = nb * 8;
    const unsigned char* U = P.ws + OFF_U;
    const unsigned char* V = P.ws + OFF_V;
    const float* US = (const float*)(P.ws + OFF_US);
    const float* VS = (const float*)(P.ws + OFF_VS);
    const float* mod = (const float*)(P.ws + OFF_MOD);
    int* slot = (int*)smem + wid * 128;
    const int kq = lane >> 4, kj = lane & 15;
    for (int sub = 0; sub < KEY_SUB; ++sub)
    for (int row = row0 + gw; row < row1; row += NGW) {
        const int* eidp = (const int*)(P.ws + OFF_EID) + (size_t)row * 128;
        const float* gwp = (const float*)(P.ws + OFF_GW) + (size_t)row * 128;
        float* cop = (float*)(P.ws + OFF_CO) + (size_t)row * 128;
        const int eme0 = eidp[lane], eme1 = eidp[64 + lane];
        const float g0 = gwp[lane], g1 = gwp[64 + lane];
        unsigned hq[16];
        const float hinv = ((const float*)(P.ws + OFF_HSC))[row];
        {
            const unsigned char* hq8 = P.ws + OFF_HQ8 + (size_t)row * DM + 16 * kj;
#pragma unroll
            for (int c = 0; c < 4; ++c) { const u32x4 t4 = *(const u32x4*)(hq8 + 256 * c); hq[4 * c] = t4.x; hq[4 * c + 1] = t4.y; hq[4 * c + 2] = t4.z; hq[4 * c + 3] = t4.w; }
        }
        int b_lo, b_hi;
        slice_list<KEY_SUB, KEY_SHIFT>(eme0, eme1, lane, sub, slot, b_lo, b_hi);
        for (int bb = b_lo; bb < b_hi; ++bb) {
            int idx[4], eidr[4];
#pragma unroll
            for (int i = 0; i < 4; ++i) {
                idx[i] = slot[16 * bb + kq + 4 * i];
                const int e0s = __shfl(eme0, idx[i] & 63), e1s = __shfl(eme1, idx[i] & 63);
                eidr[i] = (idx[i] & 64) ? e1s : e0s;
            }
            u32x4 w[4][4];
#pragma unroll
            for (int i = 0; i < 4; ++i)
#pragma unroll
                for (int c = 0; c < 4; ++c) w[i][c] = *(const u32x4*)(U + (size_t)eidr[i] * DM + 256 * c + 16 * kj);
            const int idm = (kj & 3) == 0 ? idx[0] : ((kj & 3) == 1 ? idx[1] : ((kj & 3) == 2 ? idx[2] : idx[3]));
            const int eim = (kj & 3) == 0 ? eidr[0] : ((kj & 3) == 1 ? eidr[1] : ((kj & 3) == 2 ? eidr[2] : eidr[3]));
            const float g0s = __shfl(g0, idm & 63), g1s = __shfl(g1, idm & 63);
            const float gm = (idm & 64) ? g1s : g0s;
            const float sum_ = US[eim], svm_ = VS[eim];
            int acc[4];
#pragma unroll
            for (int i = 0; i < 4; ++i) {
                int a = 0;
#pragma unroll
                for (int c = 0; c < 4; ++c) {
                    a = __builtin_amdgcn_sdot4((int)hq[4 * c + 0], (int)w[i][c].x, a, false);
                    a = __builtin_amdgcn_sdot4((int)hq[4 * c + 1], (int)w[i][c].y, a, false);
                    a = __builtin_amdgcn_sdot4((int)hq[4 * c + 2], (int)w[i][c].z, a, false);
                    a = __builtin_amdgcn_sdot4((int)hq[4 * c + 3], (int)w[i][c].w, a, false);
                }
                a += __builtin_amdgcn_mov_dpp(a, 0x128, 0xf, 0xf, true);
                a += __builtin_amdgcn_mov_dpp(a, 0x124, 0xf, 0xf, true);
                a += __builtin_amdgcn_mov_dpp(a, 0x4E, 0xf, 0xf, true);
                a += __builtin_amdgcn_mov_dpp(a, 0xB1, 0xf, 0xf, true);
                acc[i] = a;
            }
            const int tsel = (kj & 3) == 0 ? acc[0] : ((kj & 3) == 1 ? acc[1] : ((kj & 3) == 2 ? acc[2] : acc[3]));
            const float coef = gm * gelu_tanh(sum_ * hinv * (float)tsel) * svm_;
            if (kj < 4) cop[idm] = coef;
        }
    }
    asm volatile("s_waitcnt vmcnt(0)" ::: "memory");
    for (int rbase = row0 + gw; rbase < row1; rbase += VAL_GRP * NGW) {
        float out[VAL_GRP][16];
        int eme0[VAL_GRP], eme1[VAL_GRP]; float cme0[VAL_GRP], cme1[VAL_GRP];
#pragma unroll
        for (int g = 0; g < VAL_GRP; ++g) {
#pragma unroll
            for (int i = 0; i < 16; ++i) out[g][i] = 0.f;
            const int row = rbase + g * NGW;
            eme0[g] = 0; eme1[g] = 0; cme0[g] = 0.f; cme1[g] = 0.f;
            if (row < row1) {
                const int* eidp = (const int*)(P.ws + OFF_EID) + (size_t)row * 128;
                const float* cop = (const float*)(P.ws + OFF_CO) + (size_t)row * 128;
                eme0[g] = eidp[lane]; eme1[g] = eidp[64 + lane]; cme0[g] = cop[lane]; cme1[g] = cop[64 + lane];
            }
        }
        int* slotv = (int*)smem + 1024 + wid * (VAL_GRP * 144);
#pragma unroll
        for (int g = 0; g < VAL_GRP; ++g)
            if (rbase + g * NGW < row1) slice_list_all<VAL_SUB, VAL_SHIFT>(eme0[g], eme1[g], lane, slotv + g * 144, slotv + g * 144 + 128);
        for (int sub = 0; sub < VAL_SUB; ++sub) {
#pragma unroll
            for (int g = 0; g < VAL_GRP; ++g) {
                if (rbase + g * NGW >= row1) continue;
                const int* slot = slotv + g * 144;
                const int b_lo = (__builtin_amdgcn_readfirstlane(slot[128 + sub]) + 15) >> 4, b_hi = (__builtin_amdgcn_readfirstlane(slot[128 + sub + 1]) + 15) >> 4;
                for (int b0 = 16 * b_lo; b0 < 16 * b_hi; b0 += 16) {
                    const int sidx = b0 + (lane & 15);
                    const int myidx = slot[sidx];
                    const int e0s = __shfl(eme0[g], myidx & 63), e1s = __shfl(eme1[g], myidx & 63);
                    const float c0s = __shfl(cme0[g], myidx & 63), c1s = __shfl(cme1[g], myidx & 63);
                    const int eidm = (myidx & 64) ? e1s : e0s;
                    const float cm = (myidx & 64) ? c1s : c0s;
                    float ca = fabsf(cm);
                    ca = fmaxf(ca, __builtin_bit_cast(float, __builtin_amdgcn_mov_dpp(__builtin_bit_cast(int, ca), 0x128, 0xf, 0xf, true)));
                    ca = fmaxf(ca, __builtin_bit_cast(float, __builtin_amdgcn_mov_dpp(__builtin_bit_cast(int, ca), 0x124, 0xf, 0xf, true)));
                    ca = fmaxf(ca, __builtin_bit_cast(float, __builtin_amdgcn_mov_dpp(__builtin_bit_cast(int, ca), 0x4E, 0xf, 0xf, true)));
                    ca = fmaxf(ca, __builtin_bit_cast(float, __builtin_amdgcn_mov_dpp(__builtin_bit_cast(int, ca), 0xB1, 0xf, 0xf, true)));
                    const float binv = ca * (1.0f / 127.0f);
                    const unsigned qb = (unsigned)((int)rintf(cm * (ca > 0.f ? 127.0f / ca : 0.f)) & 255);
                    const int l4 = lane & ~3;
                    const unsigned pk = (unsigned)__shfl((int)qb, l4) | ((unsigned)__shfl((int)qb, l4 + 1) << 8) | ((unsigned)__shfl((int)qb, l4 + 2) << 16) | ((unsigned)__shfl((int)qb, l4 + 3) << 24);
                    int cq[4];
#pragma unroll
                    for (int r4 = 0; r4 < 4; ++r4) cq[r4] = __builtin_amdgcn_readlane((int)pk, 4 * r4);
                    int eid[16];
#pragma unroll
                    for (int k = 0; k < 16; ++k) eid[k] = __builtin_amdgcn_readlane(eidm, k);
                    u32x4 vw[16];
#pragma unroll
                    for (int e = 0; e < 16; ++e) vw[e] = *(const u32x4*)(V + (size_t)eid[e] * DM + 16 * lane);
                    int acc[16];
#pragma unroll
                    for (int i = 0; i < 16; ++i) acc[i] = 0;
#pragma unroll
                    for (int r4 = 0; r4 < 4; ++r4) {
#pragma unroll
                        for (int d = 0; d < 4; ++d) {
                            const unsigned R0 = d == 0 ? vw[4 * r4].x : (d == 1 ? vw[4 * r4].y : (d == 2 ? vw[4 * r4].z : vw[4 * r4].w));
                            const unsigned R1 = d == 0 ? vw[4 * r4 + 1].x : (d == 1 ? vw[4 * r4 + 1].y : (d == 2 ? vw[4 * r4 + 1].z : vw[4 * r4 + 1].w));
                            const unsigned R2 = d == 0 ? vw[4 * r4 + 2].x : (d == 1 ? vw[4 * r4 + 2].y : (d == 2 ? vw[4 * r4 + 2].z : vw[4 * r4 + 2].w));
                            const unsigned R3 = d == 0 ? vw[4 * r4 + 3].x : (d == 1 ? vw[4 * r4 + 3].y : (d == 2 ? vw[4 * r4 + 3].z : vw[4 * r4 + 3].w));
                            const unsigned A = __builtin_amdgcn_perm(R1, R0, 0x05010400u), B = __builtin_amdgcn_perm(R1, R0, 0x07030602u);
                            const unsigned C = __builtin_amdgcn_perm(R3, R2, 0x05010400u), D = __builtin_amdgcn_perm(R3, R2, 0x07030602u);
                            const unsigned T0 = __builtin_amdgcn_perm(C, A, 0x05040100u), T1 = __builtin_amdgcn_perm(C, A, 0x07060302u);
                            const unsigned T2 = __builtin_amdgcn_perm(D, B, 0x05040100u), T3 = __builtin_amdgcn_perm(D, B, 0x07060302u);
                            acc[4 * d + 0] = __builtin_amdgcn_sdot4((int)T0, cq[r4], acc[4 * d + 0], false);
                            acc[4 * d + 1] = __builtin_amdgcn_sdot4((int)T1, cq[r4], acc[4 * d + 1], false);
                            acc[4 * d + 2] = __builtin_amdgcn_sdot4((int)T2, cq[r4], acc[4 * d + 2], false);
                            acc[4 * d + 3] = __builtin_amdgcn_sdot4((int)T3, cq[r4], acc[4 * d + 3], false);
                        }
                    }
                    const float bs = __builtin_bit_cast(float, __builtin_amdgcn_readfirstlane(__builtin_bit_cast(int, binv)));
#pragma unroll
                    for (int i = 0; i < 16; ++i) out[g][i] += bs * (float)acc[i];
                }
            }
        }
#pragma unroll
        for (int g = 0; g < VAL_GRP; ++g) {
            const int row = rbase + g * NGW;
            if (row >= row1) continue;
            const int b = row >> 12;
            const float cb = 0.f;
            const bf16_t* x1r = (const bf16_t*)(P.ws + OFF_X1) + (size_t)row * DM + 16 * lane;
            const u32x4 xa = *(const u32x4*)(x1r), xb = *(const u32x4*)(x1r + 8);
            const float x1f[16] = {bf_lo(xa.x), bf_hi(xa.x), bf_lo(xa.y), bf_hi(xa.y), bf_lo(xa.z), bf_hi(xa.z), bf_lo(xa.w), bf_hi(xa.w),
                                   bf_lo(xb.x), bf_hi(xb.x), bf_lo(xb.y), bf_hi(xb.y), bf_lo(xb.z), bf_hi(xb.z), bf_lo(xb.w), bf_hi(xb.w)};
            const float* gf = mod + (size_t)b * 6144 + 5 * 1024 + 16 * lane;
            float x2[16]; float ss = 0.f;
#pragma unroll
            for (int q = 0; q < 4; ++q) {
                const f32x4 xv = {x1f[4 * q], x1f[4 * q + 1], x1f[4 * q + 2], x1f[4 * q + 3]}, gg = *(const f32x4*)(gf + 4 * q);
                const int o = 4 * q;
                x2[o] = xv.x + gg.x * (out[g][o] - cb); x2[o + 1] = xv.y + gg.y * (out[g][o + 1] - cb); x2[o + 2] = xv.z + gg.z * (out[g][o + 2] - cb); x2[o + 3] = xv.w + gg.w * (out[g][o + 3] - cb);
                ss += (x2[o] * x2[o] + x2[o + 1] * x2[o + 1]) + (x2[o + 2] * x2[o + 2] + x2[o + 3] * x2[o + 3]);
            }
            const float rstd = __builtin_amdgcn_rsqf(wave_sum(ss) * (1.0f / DM) + RMS_EPS);
            float* orow = P.out + (size_t)row * DM + 16 * lane;
#pragma unroll
            for (int q = 0; q < 4; ++q) {
                const int o = 4 * q;
                const f32x4 gg = *(const f32x4*)(P.final_g + 16 * lane + 4 * q);
                *(f32x4*)(orow + 4 * q) = (f32x4){x2[o] * rstd * gg.x, x2[o + 1] * rstd * gg.y, x2[o + 2] * rstd * gg.z, x2[o + 3] * rstd * gg.w};
            }
        }
    }
}

#define XB_TMO      128
#define XB_XCNT(j)  (256  + 64 * (j))
#define XB_XSUB(j)  (1280 + 64 * (j))
#define XB_XGEN(j)  (2304 + 64 * (j))
#define XB_TOP      3328
#define XB_TOPGEN   3392
#define XCD_BAR_WORDS 3456
#define XB_SPIN_CAP (1u << 18)

__device__ __forceinline__ unsigned xb_ld(unsigned* p)              { return __hip_atomic_load(p, __ATOMIC_RELAXED, __HIP_MEMORY_SCOPE_AGENT); }
__device__ __forceinline__ unsigned xb_add(unsigned* p, unsigned v) { return __hip_atomic_fetch_add(p, v, __ATOMIC_RELAXED, __HIP_MEMORY_SCOPE_AGENT); }
__device__ __forceinline__ unsigned xb_xcc_id() { return (unsigned)__builtin_amdgcn_s_getreg((3 << 11) | 20) & 0xFu; }
#define XB_SPIN(cond, bar) do { unsigned _sp = 0; while (cond) { __builtin_amdgcn_s_sleep(1); \
    if ((++_sp & 255u) == 0u) { if (xb_ld(&(bar)[XB_TMO])) break; if (_sp > XB_SPIN_CAP) { atomicAdd(&(bar)[XB_TMO], 1u); break; } } } } while (0)

struct XcdBarrier {
    unsigned* bar; unsigned x;
    volatile LAS3 unsigned* st;
};

__device__ __forceinline__ XcdBarrier xcd_barrier_post(unsigned* bar, volatile LAS3 unsigned* st) {
    XcdBarrier b; b.bar = bar; b.x = xb_xcc_id(); b.st = st;
    if (threadIdx.x == 0) (void)xb_add(&bar[XB_XCNT(b.x)], 1u);
    return b;
}
__device__ __forceinline__ void xcd_barrier_complete(unsigned* bar, unsigned x, unsigned& nloc, unsigned& nx) {
    const unsigned G = gridDim.x * gridDim.y * gridDim.z;
    unsigned sum, cnt, mine, sp = 0u;
    for (;;) {
        sum = 0u; cnt = 0u; mine = 0u;
#pragma unroll
        for (unsigned j = 0; j < 16; ++j) { const unsigned c = xb_ld(&bar[XB_XCNT(j)]); sum += c; cnt += (c > 0u) ? 1u : 0u; mine = (j == x) ? c : mine; }
        if (sum == G) break;
        __builtin_amdgcn_s_sleep(1);
        if ((++sp & 255u) == 0u) { if (xb_ld(&bar[XB_TMO])) break; if (sp > XB_SPIN_CAP) { atomicAdd(&bar[XB_TMO], 1u); break; } }
    }
    nloc = mine > 0u ? mine : 1u; nx = cnt > 0u ? cnt : 1u;
}

__device__ __forceinline__ void xcd_barrier(const XcdBarrier& b) {
    asm volatile("s_waitcnt vmcnt(0)" ::: "memory");
    __syncthreads();
    if (threadIdx.x == 0) {
        unsigned* bar = b.bar;
        __builtin_amdgcn_s_waitcnt(0);
        unsigned nloc = b.st[0], nx = b.st[1];
        if (nloc == 0u) { xcd_barrier_complete(bar, b.x, nloc, nx); b.st[0] = nloc; b.st[1] = nx; }
        const unsigned old = xb_add(&bar[XB_XSUB(b.x)], 1u);
        const unsigned gen = old / nloc;
        if (old + 1u == (gen + 1u) * nloc) {
            __builtin_amdgcn_fence(__ATOMIC_RELEASE, "agent");
            asm volatile("s_waitcnt vmcnt(0)" ::: "memory");
            const unsigned og = xb_add(&bar[XB_TOP], 1u);
            const unsigned tg = og / nx;
            if (og + 1u == (tg + 1u) * nx) xb_add(&bar[XB_TOPGEN], 1u);
            else XB_SPIN(xb_ld(&bar[XB_TOPGEN]) == tg, bar);
            __builtin_amdgcn_fence(__ATOMIC_ACQUIRE, "agent");
            xb_add(&bar[XB_XGEN(b.x)], 1u);
            asm volatile("s_waitcnt vmcnt(0)" ::: "memory");
        } else {
            XB_SPIN(xb_ld(&bar[XB_XGEN(b.x)]) == gen, bar);
            __builtin_amdgcn_fence(__ATOMIC_ACQUIRE, "agent");
            asm volatile("s_waitcnt vmcnt(0)" ::: "memory");
        }
    }
    __syncthreads();
}


#define XB_GRP 3520
__device__ __forceinline__ void group_barrier(unsigned* bar, unsigned members, unsigned& target) {
    asm volatile("s_waitcnt vmcnt(0)" ::: "memory");
    __syncthreads();
    target += members;
    if (threadIdx.x == 0) {
        __builtin_amdgcn_s_waitcnt(0);
        __builtin_amdgcn_fence(__ATOMIC_RELEASE, "agent");
        asm volatile("s_waitcnt vmcnt(0)" ::: "memory");
        (void)xb_add(&bar[XB_GRP], 1u);
        XB_SPIN(xb_ld(&bar[XB_GRP]) < target, bar);
        __builtin_amdgcn_fence(__ATOMIC_ACQUIRE, "agent");
        asm volatile("s_waitcnt vmcnt(0)" ::: "memory");
    }
    __syncthreads();
}

constexpr int N_PHASES = 11;
__global__ void __launch_bounds__(NTHREADS) fwd_kernel(Params P) {
    extern __shared__ __attribute__((aligned(16))) char smem[];
    cg::grid_group grid = cg::this_grid();
    const int lo = P.ph_lo, hi = P.ph_hi;
    const int G = gridDim.x, bid = blockIdx.x;
#ifndef REP_PHASE
#define REP_PHASE -1
#endif
#define IN(k) (lo <= (k) && (k) < hi)
#define REPS(k) for (int rep_ = 0; rep_ < ((k) == REP_PHASE ? 2 : 1); ++rep_)
    volatile LAS3 unsigned* bst = (volatile LAS3 unsigned*)((LAS3 char*)smem + (LDS_BYTES - 16));
    if (threadIdx.x < 2) bst[threadIdx.x] = 0u;
    __syncthreads();
    XcdBarrier xbar = xcd_barrier_post((unsigned*)(P.ws + OFF_BAR), bst);
    if (lo > 1000) grid.sync();
#define SEAM(k) do { if (IN(k) && IN((k) + 1)) xcd_barrier(xbar); } while (0)
    const bool defer_late = G > 128 && lo == 0 && hi > 3;
    REPS(0) if (IN(0)) { if (defer_late) phase_prologue<0>(P, smem, bid, G); else phase_prologue<2>(P, smem, bid, G); }
    SEAM(0);
    REPS(1) if (IN(1)) phase_normmod<false>(P, P.x, P.norm1_g, 0, 1, (bf16_t*)(P.ws + OFF_H));
    SEAM(1);
    REPS(2) if (IN(2)) {
        {
            const pg8::Gemm g{(const bf16_t*)(P.ws + OFF_H), (const bf16_t*)(P.ws + OFF_WINT), NTOK, 2304, DM};
            pg8::StaticOrder S; S.init(NTOK, 2304, G, bid);
            const EpiPg8<EpiInProj> E{EpiInProj{P.ws}};
            pg8::gemm_phase<EpiPg8<EpiInProj>, pg8::StaticOrder, true, true>((PG8_LAS unsigned char*)smem, g, S, E);
        }
        {
            const pg8::Gemm g{(const bf16_t*)(P.ws + OFF_WINT) + (size_t)2304 * DM, (const bf16_t*)(P.ws + OFF_H), 768, NTOK, DM};
            pg8::StaticOrder S; S.init(768, NTOK, G, bid);
            const EpiPg8<EpiInProjT> E{EpiInProjT{P.ws}};
            pg8::gemm_phase<EpiPg8<EpiInProjT>, pg8::StaticOrder, true, true>((PG8_LAS unsigned char*)smem, g, S, E);
        }
    }
    SEAM(2);
    REPS(3) if (IN(3)) {
        if (defer_late && bid >= 128) phase_prologue<1>(P, smem, bid - 128, G - 128);
        for (int u = bid; u < 2 * 32 * 2; u += (defer_late ? 128 : G)) {
            if (defer_late && bid >= 128) break;
            const int kv = u >> 6, mt = (u >> 1) & 31, nt = u & 1;
            const ACmp af{(const bf16_t*)(P.ws + (kv ? OFF_VC : OFF_KC))};
            const EpiCmp1 epi{(bf16_t*)(P.ws + OFF_HID) + (size_t)kv * 8192 * 256, (const float*)(P.ws + OFF_PB) + kv * 256};
            gemm_tile<false>(smem, af, (const bf16_t*)(P.ws + OFF_W1T) + (size_t)kv * 256 * 2048, 2048, mt * 256, nt * 128, 32, epi);
        }
    }
    SEAM(3);
    REPS(4) if (IN(4)) {
        for (int u = bid; u < 2 * 32; u += G) {
            const int kv = u >> 5, mt = u & 31;
            const ARowMajor af{(const bf16_t*)(P.ws + OFF_HID) + (size_t)kv * 8192 * 256, 256};
            const EpiCmp2 epi{(bf16_t*)(P.ws + OFF_KCMP), (bf16_t*)(P.ws + OFF_VCMPT)};
            const bf16_t* Bt = (const bf16_t*)(P.ws + OFF_W2T) + (size_t)kv * 128 * 256;
            if (kv) gemm_tile<true>(smem, af, Bt, 256, mt * 256, 0, 4, epi);
            else gemm_tile<false>(smem, af, Bt, 256, mt * 256, 0, 4, epi);
        }
    }
    SEAM(4);
    REPS(5) if (IN(5)) phase_attention(P, smem);
    SEAM(5);
    REPS(6) if (IN(6)) {
        const pg8::Gemm g{(const bf16_t*)(P.ws + OFF_H), (const bf16_t*)(P.ws + OFF_WOUTT), NTOK, DM, DM};
        pg8::StaticOrder S; S.init(NTOK, DM, G, bid);
        const EpiPg8<EpiOutProj> E{EpiOutProj{P.x, (const float*)(P.ws + OFF_MOD), (bf16_t*)(P.ws + OFF_X1)}};
        pg8::gemm_phase<EpiPg8<EpiOutProj>, pg8::StaticOrder, true, true>((PG8_LAS unsigned char*)smem, g, S, E);
    }
    SEAM(6);
    REPS(7) if (IN(7)) phase_normmod<true>(P, P.ws + OFF_X1, P.norm2_g, 3, 4, (bf16_t*)(P.ws + OFF_H));
    SEAM(7);
    REPS(8) if (IN(8)) {
        const pg8::Gemm g{(const bf16_t*)(P.ws + OFF_H), (const bf16_t*)(P.ws + OFF_WQT), NTOK, 2048, DM};
        pg8::StaticOrder S; S.init(NTOK, 2048, G, bid);
        const EpiPg8<EpiWq> E{EpiWq{(bf16_t*)(P.ws + OFF_QP)}};
        pg8::gemm_phase<EpiPg8<EpiWq>, pg8::StaticOrder, true, true>((PG8_LAS unsigned char*)smem, g, S, E);
    }
    SEAM(8);
    REPS(9) if (IN(9)) phase_retrieval(P, smem);
    SEAM(9);
    REPS(10) if (IN(10)) phase_experts(P, smem);
#undef IN
#undef SEAM
}

extern "C" void kernel_launch(void* const* d_in, const int* in_sizes, int n_in, void* d_out, int out_size, void* d_ws, size_t ws_size, hipStream_t stream) {
    static int grid = 0;
    if (grid == 0) {
        if (n_in != 22 || in_sizes[0] != NTOK * DM || out_size != NTOK * DM || ws_size < WS_NEED) {
            fprintf(stderr, "kernel_launch: unexpected shapes (n_in %d, in0 %d, out %d, ws %zu); nothing launched\n", n_in, n_in > 0 ? in_sizes[0] : -1, out_size, ws_size);
            grid = -1; return;
        }
        int dev = 0, cus = 0, per_cu = 0;
        (void)hipGetDevice(&dev);
        (void)hipDeviceGetAttribute(&cus, hipDeviceAttributeMultiprocessorCount, dev);
        if (hipFuncSetAttribute((const void*)fwd_kernel, hipFuncAttributeMaxDynamicSharedMemorySize, LDS_BYTES) != hipSuccess) { fprintf(stderr, "kernel_launch: hipFuncSetAttribute failed\n"); grid = -1; return; }
        if (hipOccupancyMaxActiveBlocksPerMultiprocessor(&per_cu, (const void*)fwd_kernel, NTHREADS, LDS_BYTES) != hipSuccess || per_cu < 1) { fprintf(stderr, "kernel_launch: occupancy query failed (%d)\n", per_cu); (void)hipGetLastError(); per_cu = 1; }
        if (per_cu > 1) per_cu = 1;
        grid = cus * per_cu;
        if (grid <= 0) grid = 256;
    }
    if (grid < 0) return;
    if (hipMemsetAsync((char*)d_ws + OFF_BAR, 0, 16384, stream) != hipSuccess) { fprintf(stderr, "kernel_launch: hipMemsetAsync failed\n"); return; }
    Params p{};
    const float** pp = (const float**)&p;
    for (int i = 0; i < 22; ++i) pp[i] = (const float*)d_in[i];
    p.out = (float*)d_out; p.ws = (unsigned char*)d_ws;
#if MK_SPLIT
    for (int ph = 0; ph < N_PHASES; ++ph) {
        p.ph_lo = ph; p.ph_hi = ph + 1;
        void* args[] = {&p};
        hipError_t e = hipLaunchCooperativeKernel((const void*)fwd_kernel, dim3(grid), dim3(NTHREADS), args, LDS_BYTES, stream);
        if (e != hipSuccess) { fprintf(stderr, "kernel_launch: launch of phase %d failed: %s\n", ph, hipGetErrorString(e)); break; }
    }
#else
    p.ph_lo = 0; p.ph_hi = N_PHASES;
    void* args[] = {&p};
    hipError_t e = hipLaunchCooperativeKernel((const void*)fwd_kernel, dim3(grid), dim3(NTHREADS), args, LDS_BYTES, stream);
    if (e != hipSuccess) fprintf(stderr, "kernel_launch: cooperative launch failed: %s (grid %d)\n", hipGetErrorString(e), grid);
#endif
}
```
